# Optimizing an MI355X kernel written in HIP

```python
import math
import jax, jax.numpy as jnp
from jax import lax
import numpy as np


D_MODEL = 1024
BATCH = 4
SEQ = 4096
DEPTH = 2

HEAD_DIM = 64
BLOCK = 128
EPS = 1e-6
RET_HEADS = 4
RET_QK_DIM = 64
RET_V_DIM = 128
RET_CHUNK = 128
RET_THETA = 10000.0
DIL_HEADS = 8
DIL_PATTERNS = ((128, 1), (512, 4), (2048, 16))
SWA_Q_HEADS = 16
SWA_KV_HEADS = 4
SWA_WINDOW = 128
ROPE_THETA = 500000.0
ROPE_DIMS = HEAD_DIM // 4
D_FF = 4 * D_MODEL
EVEN_SPLITS = (RET_HEADS * RET_QK_DIM, RET_HEADS * RET_QK_DIM, RET_HEADS * RET_V_DIM, RET_HEADS * RET_V_DIM,
               DIL_HEADS * HEAD_DIM, DIL_HEADS * HEAD_DIM, DIL_HEADS * HEAD_DIM)
EVEN_IN = sum(EVEN_SPLITS)
EVEN_MIX = RET_HEADS * RET_V_DIM + DIL_HEADS * HEAD_DIM
SWA_SPLITS = (SWA_Q_HEADS * HEAD_DIM, SWA_KV_HEADS * HEAD_DIM, SWA_KV_HEADS * HEAD_DIM)
SWA_IN = sum(SWA_SPLITS)
SWA_MIX = SWA_Q_HEADS * HEAD_DIM

kernel_name = 'hybrid_retention_dilated_swa_block'


def rmsnorm(x, g):
    xf = x.astype(jnp.float32)
    y = xf * lax.rsqrt(jnp.mean(xf * xf, axis=-1, keepdims=True) + EPS)
    return (y * g.astype(jnp.float32)).astype(x.dtype)


def to_heads(t, n_heads):
    b, s, _ = t.shape
    return t.reshape(b, s, n_heads, -1).transpose(0, 2, 1, 3)


def from_heads(t):
    b, h, s, d = t.shape
    return t.transpose(0, 2, 1, 3).reshape(b, s, h * d)


def rope(x, pos, n_rot, theta):
    half = n_rot // 2
    inv = jnp.power(jnp.float32(theta), -jnp.arange(half, dtype=jnp.float32) * (2.0 / n_rot))
    ang = pos.astype(jnp.float32)[:, None, :, None] * inv
    cos, sin = jnp.cos(ang), jnp.sin(ang)
    xf = x.astype(jnp.float32)
    x1, x2, rest = xf[..., :half], xf[..., half:n_rot], xf[..., n_rot:]
    return jnp.concatenate([x1 * cos - x2 * sin, x2 * cos + x1 * sin, rest], axis=-1)


def banded_attn(q, k, v, max_dist, sinks=None):
    b, hk, g, L, d = q.shape
    bs = math.gcd(L, BLOCK)
    nb = L // bs
    P = max_dist
    kp = jnp.pad(k.astype(jnp.float32), ((0, 0), (0, 0), (P, 0), (0, 0)))
    vp = jnp.pad(v.astype(jnp.float32), ((0, 0), (0, 0), (P, 0), (0, 0)))
    idx = (jnp.arange(nb) * bs)[:, None] + jnp.arange(bs + P)[None, :]
    kb = kp[:, :, idx]
    vb = vp[:, :, idx]
    qb = q.astype(jnp.float32).reshape(b, hk, g, nb, bs, d)
    s = jnp.einsum('bhgnqd,bhnkd->bhgnqk', qb, kb) * (d ** -0.5)
    qpos = jnp.arange(L).reshape(nb, bs)
    kpos = idx - P
    dist = qpos[:, :, None] - kpos[:, None, :]
    valid = (dist >= 0) & (dist <= max_dist) & (kpos[:, None, :] >= 0)
    s = jnp.where(valid, s, -jnp.inf)
    m = jnp.max(s, axis=-1, keepdims=True)
    if sinks is not None:
        sk = sinks.astype(jnp.float32).reshape(1, hk, g, 1, 1, 1)
        m = jnp.maximum(m, sk)
    p = jnp.exp(s - m)
    den = jnp.sum(p, axis=-1, keepdims=True)
    if sinks is not None:
        den = den + jnp.exp(sk - m)
    o = jnp.einsum('bhgnqk,bhnkd->bhgnqd', p, vb) / den
    lse = (m + jnp.log(den))[..., 0]
    return o.reshape(b, hk, g, L, d), lse.reshape(b, hk, g, L)


def dilated_attention(q, k, v):
    b, h, S, d = q.shape
    outs, lses = [], []
    for w, r in DIL_PATTERNS:
        L = S // r
        def split(t):
            return t.reshape(b, h, L, r, d).transpose(0, 1, 3, 2, 4).reshape(b, h * r, L, d)
        o, lse = banded_attn(split(q)[:, :, None], split(k), split(v), w // r)
        outs.append(o[:, :, 0].reshape(b, h, r, L, d).transpose(0, 1, 3, 2, 4).reshape(b, h, S, d))
        lses.append(lse[:, :, 0].reshape(b, h, r, L).transpose(0, 1, 3, 2).reshape(b, h, S))
    wts = jax.nn.softmax(jnp.stack(lses, axis=0), axis=0)
    return jnp.sum(wts[..., None] * jnp.stack(outs, axis=0), axis=0)


def retention(q, k, v):
    b, h, S, dk = q.shape
    dv = v.shape[-1]
    C = math.gcd(S, RET_CHUNK)
    nc = S // C
    log_gamma = jnp.log1p(-jnp.exp2(-5.0 - jnp.arange(h, dtype=jnp.float32)))
    qc = q.reshape(b, h, nc, C, dk)
    kc = k.reshape(b, h, nc, C, dk)
    vc = v.astype(jnp.float32).reshape(b, h, nc, C, dv)
    i = jnp.arange(C, dtype=jnp.float32)
    diff = i[:, None] - i[None, :]
    decay = jnp.where(diff >= 0, jnp.exp(log_gamma[:, None, None] * jnp.maximum(diff, 0.0)), 0.0)
    scores = jnp.einsum('bhncd,bhnkd->bhnck', qc, kc) * decay[None, :, None]
    o_inner = jnp.einsum('bhnck,bhnkv->bhncv', scores, vc)
    xi = jnp.exp(log_gamma[:, None] * (i + 1.0))
    zeta = jnp.exp(log_gamma[:, None] * (C - 1.0 - i))
    chunk_decay = jnp.exp(log_gamma * C)
    kz = kc * zeta[None, :, None, :, None]

    def step(R, inp):
        q_n, kz_n, v_n = inp
        o = jnp.einsum('bhcd,bhdv->bhcv', q_n, R)
        R = R * chunk_decay[None, :, None, None] + jnp.einsum('bhcd,bhcv->bhdv', kz_n, v_n)
        return R, o

    R0 = jnp.zeros((b, h, dk, dv), jnp.float32)
    _, o_cross = lax.scan(step, R0, (qc.transpose(2, 0, 1, 3, 4), kz.transpose(2, 0, 1, 3, 4),
                                     vc.transpose(2, 0, 1, 3, 4)))
    o_cross = o_cross.transpose(1, 2, 0, 3, 4) * xi[None, :, None, :, None]
    return (o_inner + o_cross).reshape(b, h, S, dv)


def even_mixer(h, positions, w_in, w_out, gn_gain, q_gain, k_gain):
    proj = h @ w_in
    cuts = [int(c) for c in np.cumsum(EVEN_SPLITS)[:-1]]
    rq, rk, rv, rg, dq, dk, dv = jnp.split(proj, cuts, axis=-1)
    rq = rope(to_heads(rq, RET_HEADS), positions, RET_QK_DIM, RET_THETA)
    rk = rope(to_heads(rk, RET_HEADS), positions, RET_QK_DIM, RET_THETA) * (RET_QK_DIM ** -0.5)
    ro = retention(rq, rk, to_heads(rv, RET_HEADS))
    mu = jnp.mean(ro, axis=-1, keepdims=True)
    var = jnp.mean(jnp.square(ro - mu), axis=-1, keepdims=True)
    ro = (ro - mu) * lax.rsqrt(var + EPS) * gn_gain.astype(jnp.float32)[None, :, None, :]
    ra = jax.nn.silu(rg.astype(jnp.float32)) * from_heads(ro)
    dq = rope(rmsnorm(to_heads(dq, DIL_HEADS), q_gain), positions, ROPE_DIMS, ROPE_THETA)
    dk = rope(rmsnorm(to_heads(dk, DIL_HEADS), k_gain), positions, ROPE_DIMS, ROPE_THETA)
    da = from_heads(dilated_attention(dq, dk, to_heads(dv, DIL_HEADS).astype(jnp.float32)))
    mixed = jnp.concatenate([ra, da], axis=-1).astype(h.dtype)
    return mixed @ w_out


def swa_mixer(h, positions, w_qkv, b_qkv, w_out, q_gain, k_gain, sinks):
    b, S, _ = h.shape
    g = SWA_Q_HEADS // SWA_KV_HEADS
    proj = h @ w_qkv + b_qkv
    cuts = [int(c) for c in np.cumsum(SWA_SPLITS)[:-1]]
    q, k, v = jnp.split(proj, cuts, axis=-1)
    q = rope(rmsnorm(to_heads(q, SWA_Q_HEADS), q_gain), positions, ROPE_DIMS, ROPE_THETA)
    k = rope(rmsnorm(to_heads(k, SWA_KV_HEADS), k_gain), positions, ROPE_DIMS, ROPE_THETA)
    v = to_heads(v, SWA_KV_HEADS)
    q = q.reshape(b, SWA_KV_HEADS, g, S, HEAD_DIM)
    o, _ = banded_attn(q, k, v, SWA_WINDOW - 1, sinks.reshape(SWA_KV_HEADS, g))
    o = o.reshape(b, SWA_Q_HEADS, S, HEAD_DIM)
    return from_heads(o).astype(h.dtype) @ w_out


def sq_relu_mlp(h, w_up, w_down):
    return jnp.square(jax.nn.relu(h @ w_up)) @ w_down


def setup_inputs(seed: int = 0) -> dict:
    key = jax.random.key(seed)
    ks = jax.random.split(key, 20)
    ne, no = (DEPTH + 1) // 2, DEPTH // 2
    f32 = jnp.float32

    def w(k, shape, fan_in):
        return jax.random.normal(k, shape, f32) * (fan_in ** -0.5)

    def gain(k, shape):
        return 1.0 + 0.05 * jax.random.normal(k, shape, f32)

    return {
        'x': jax.random.normal(ks[0], (BATCH, SEQ, D_MODEL), f32),
        'positions': jnp.broadcast_to(jnp.arange(SEQ, dtype=jnp.int32), (BATCH, SEQ)),
        'norm_mix': gain(ks[1], (DEPTH, D_MODEL)),
        'norm_mlp': gain(ks[2], (DEPTH, D_MODEL)),
        'mlp_w_up': w(ks[3], (DEPTH, D_MODEL, D_FF), D_MODEL),
        'mlp_w_down': w(ks[4], (DEPTH, D_FF, D_MODEL), D_FF),
        'hyb_w_in': w(ks[5], (ne, D_MODEL, EVEN_IN), D_MODEL),
        'hyb_w_out': w(ks[6], (ne, EVEN_MIX, D_MODEL), EVEN_MIX),
        'ret_gn_gain': gain(ks[7], (ne, RET_HEADS, RET_V_DIM)),
        'dil_q_gain': gain(ks[8], (ne, HEAD_DIM)),
        'dil_k_gain': gain(ks[9], (ne, HEAD_DIM)),
        'swa_w_qkv': w(ks[10], (no, D_MODEL, SWA_IN), D_MODEL),
        'swa_b_qkv': 0.02 * jax.random.normal(ks[11], (no, SWA_IN), f32),
        'swa_w_out': w(ks[12], (no, SWA_MIX, D_MODEL), SWA_MIX),
        'swa_q_gain': gain(ks[13], (no, HEAD_DIM)),
        'swa_k_gain': gain(ks[14], (no, HEAD_DIM)),
        'swa_sinks': 0.5 * jax.random.normal(ks[15], (no, SWA_Q_HEADS), f32),
    }


def reference(x, positions, norm_mix, norm_mlp, mlp_w_up, mlp_w_down, hyb_w_in, hyb_w_out,
              ret_gn_gain, dil_q_gain, dil_k_gain, swa_w_qkv, swa_b_qkv, swa_w_out,
              swa_q_gain, swa_k_gain, swa_sinks):
    for layer in range(DEPTH):
        i = layer // 2
        h = rmsnorm(x, norm_mix[layer])
        if layer % 2 == 0:
            x = x + even_mixer(h, positions, hyb_w_in[i], hyb_w_out[i], ret_gn_gain[i],
                               dil_q_gain[i], dil_k_gain[i])
        else:
            x = x + swa_mixer(h, positions, swa_w_qkv[i], swa_b_qkv[i], swa_w_out[i],
                              swa_q_gain[i], swa_k_gain[i], swa_sinks[i])
        h = rmsnorm(x, norm_mlp[layer])
        x = x + sq_relu_mlp(h, mlp_w_up[layer], mlp_w_down[layer])
    return x
```

```cpp
#include <hip/hip_runtime.h>
#include <hip/hip_cooperative_groups.h>
#include <cstdio>
#include <cstdint>
namespace cg = cooperative_groups;
namespace pg8 {
#define PG8_LAS __attribute__((address_space(3)))
typedef unsigned short bf16_t;
typedef short bf16x8 __attribute__((ext_vector_type(8)));
typedef float f32x4 __attribute__((ext_vector_type(4)));
typedef unsigned u32x4 __attribute__((ext_vector_type(4)));
constexpr int BM = 256, BK = 64, HALF = 128, HTB = HALF * BK * 2  , STAGE_BYTES = 8 * HTB, NXCD = 8, WGM = 8;

__host__ __device__ __forceinline__ int lds_byte(int r, int c) { const int st = (r >> 4) * 2 + (c >> 5), rr = r & 15, cc = c & 31, ob = rr * 64 + cc * 2; return st * 1024 + (ob ^ (((ob >> 9) & 1) << 5)); }
__host__ __device__ __forceinline__ void stage_rc(int b, int& R, int& C) { const int st = b / 1024, sb = b % 1024, swz = sb ^ (((sb >> 9) & 1) << 5); R = (st >> 1) * 16 + swz / 64; C = (st & 1) * 32 + (swz % 64) / 2; }
__host__ __device__ __forceinline__ int perm32(int rho) { const int n = rho >> 4, i = rho & 15; return 8 * (i >> 2) + 4 * n + (i & 3); }

struct Unit { int pm, pn; };
struct Gemm { const bf16_t* A; const bf16_t* Bt; int M, N, K; };

struct StaticOrder {
    int nM, nN, nwg, G, c;
    __host__ __device__ void init(int M, int N, int G_, int c_) { nM = M / BM; nN = N / BM; nwg = nM * nN; G = G_; c = c_; }
    __host__ __device__ bool next(int i, Unit& u) const {
        const long L = (long)i * G + c; if (L >= nwg) return false;
        int wgid = (int)L; { const int q = nwg / NXCD, r = nwg % NXCD, xcd = wgid % NXCD, off = wgid / NXCD; wgid = (xcd < r ? xcd * (q + 1) : r * (q + 1) + (xcd - r) * q) + off; }
        const int nig = WGM * nN, gid = wgid / nig, fm = gid * WGM, gsz = (nM - fm) < WGM ? (nM - fm) : WGM;
        u.pm = fm + ((wgid % nig) % gsz); u.pn = (wgid % nig) / gsz; return true;
    }
    __device__ __forceinline__ void a_ready(const Unit&) const {}
    __device__ __forceinline__ void done(const Unit&) const {}
};

__device__ __forceinline__ unsigned cvt_pk_bf16(float lo, float hi) { typedef __bf16 b2 __attribute__((ext_vector_type(2))); typedef float f2 __attribute__((ext_vector_type(2))); f2 v = {lo, hi}; return __builtin_bit_cast(unsigned, __builtin_convertvector(v, b2)); }
template <class Epi, class Sched, bool ALIGN_EPI = false, bool SP2 = false>
__device__ __forceinline__ void gemm_phase(PG8_LAS unsigned char* lds, const Gemm g, const Sched& S, const Epi& E) {
    const int tid = threadIdx.x, wid = __builtin_amdgcn_readfirstlane(tid >> 6), lane = tid & 63, wr = wid >> 2, wc = wid & 3, fr = lane & 15, fq = lane >> 4;
    const int K = g.K, nt = K / BK;
    unsigned voffA[2], voffB[2];
#pragma unroll
    for (int i = 0; i < 2; ++i) { int R, C; stage_rc(tid * 16 + i * 8192, R, C); const int Rb = Epi::PERM ? ((R & ~31) + perm32(R & 31)) : R;
        voffA[i] = (unsigned)(R * K + C) * 2u; voffB[i] = (unsigned)(Rb * K + C) * 2u; }
    const size_t kstep = (size_t)(BK * 2);
    const size_t hstep = (size_t)HALF * K * 2;
    const size_t tstep = 2 * hstep;
    const unsigned ldsw = (unsigned)wid * 1024u;
    const int aoff = lds_byte(wr * 64 + fr, fq * 8), boff = lds_byte(wc * 32 + fr, fq * 8);
#define PG8_SA(b, h) (((b) * 2 + (h)) * HTB)
#define PG8_SB(b, h) ((4 + (b) * 2 + (h)) * HTB)
#define PG8_STAGE(bufoff, gbase, voff) do { _Pragma("unroll") for (int _i = 0; _i < 2; ++_i) \
        __builtin_amdgcn_global_load_lds((const unsigned*)((const char*)(gbase) + (voff)[_i]), (PG8_LAS unsigned*)(lds + (bufoff) + ldsw + _i * 8192), 16, 0, 0); } while (0)
#define PG8_LDA(dst, b, h) do { _Pragma("unroll") for (int m = 0; m < 4; ++m) _Pragma("unroll") for (int k = 0; k < 2; ++k) dst[m][k] = *(const PG8_LAS bf16x8*)(lds + PG8_SA(b, h) + aoff + m * 2048 + k * 1024); } while (0)
#define PG8_LDB(dst, b, h) do { _Pragma("unroll") for (int n = 0; n < 2; ++n) _Pragma("unroll") for (int k = 0; k < 2; ++k) dst[n][k] = *(const PG8_LAS bf16x8*)(lds + PG8_SB(b, h) + boff + n * 2048 + k * 1024); } while (0)
#define PG8_MMA(ai, bj, At, Bt) do { __builtin_amdgcn_s_setprio(1); _Pragma("unroll") for (int m = 0; m < 4; ++m) _Pragma("unroll") for (int n = 0; n < 2; ++n) _Pragma("unroll") for (int k = 0; k < 2; ++k) \
        acc[ai][bj][m][n] = __builtin_amdgcn_mfma_f32_16x16x32_bf16(Bt[n][k], At[m][k], acc[ai][bj][m][n], 0, 0, 0); __builtin_amdgcn_s_setprio(0); } while (0)
#define PG8_WAIT_V(n) asm volatile("s_waitcnt vmcnt(" #n ")" ::: "memory")
#define PG8_WAIT_L(n) asm volatile("s_waitcnt lgkmcnt(" #n ")" ::: "memory")
#define PG8_BAR __builtin_amdgcn_s_barrier()
#define PG8_SCHED __builtin_amdgcn_sched_barrier(0)
    Unit cur, nxt; int ui = 0;
    if (!S.next(0, cur)) return;
    f32x4 acc[2][2][4][2];
#pragma unroll
    for (int a = 0; a < 2; ++a)
#pragma unroll
        for (int b = 0; b < 2; ++b)
#pragma unroll
            for (int m = 0; m < 4; ++m)
#pragma unroll
                for (int n = 0; n < 2; ++n) acc[a][b][m][n] = (f32x4){0.f, 0.f, 0.f, 0.f};
    bf16x8 At[4][2], B0[2][2], B1[2][2];
    const char* cA = (const char*)g.A + (size_t)cur.pm * tstep; const char* cB = (const char*)g.Bt + (size_t)cur.pn * tstep;
    S.a_ready(cur);
    if constexpr (SP2) {
        PG8_STAGE(PG8_SB(0, 0), cB, voffB); PG8_STAGE(PG8_SB(0, 1), cB + hstep, voffB); PG8_STAGE(PG8_SA(0, 0), cA, voffA); PG8_STAGE(PG8_SA(0, 1), cA + hstep, voffA);
        if (wr == 1) PG8_BAR;
        PG8_WAIT_V(2); PG8_BAR;
        PG8_STAGE(PG8_SB(1, 0), cB + kstep, voffB); PG8_STAGE(PG8_SA(1, 0), cA + kstep, voffA); PG8_STAGE(PG8_SB(1, 1), cB + hstep + kstep, voffB);
        PG8_WAIT_V(6); PG8_BAR;
    } else {
        PG8_STAGE(PG8_SB(0, 0), cB, voffB); PG8_STAGE(PG8_SA(0, 0), cA, voffA); PG8_STAGE(PG8_SB(0, 1), cB + hstep, voffB); PG8_STAGE(PG8_SA(0, 1), cA + hstep, voffA);
        if (wr == 1) PG8_BAR;
        PG8_WAIT_V(4); PG8_BAR;
        PG8_STAGE(PG8_SB(1, 0), cB + kstep, voffB); PG8_STAGE(PG8_SA(1, 0), cA + kstep, voffA); PG8_STAGE(PG8_SB(1, 1), cB + hstep + kstep, voffB);
        PG8_WAIT_V(6); PG8_BAR;
    }
    for (;;) {
        const bool has_next = S.next(ui + 1, nxt);
        const char* nA = has_next ? (const char*)g.A + (size_t)nxt.pm * tstep : cA; const char* nB = has_next ? (const char*)g.Bt + (size_t)nxt.pn * tstep : cB;
        for (int t = 0; t < nt; t += 2) {
            const bool last = (t == nt - 2);
            const char* a1 = cA + (size_t)(t + 1) * kstep;
            const char* a2 = last ? nA : cA + (size_t)(t + 2) * kstep; const char* b2 = last ? nB : cB + (size_t)(t + 2) * kstep;
            const char* a3 = a2 + kstep; const char* b3 = b2 + kstep;
            if (last && has_next) S.a_ready(nxt);
            if constexpr (SP2) {
            PG8_LDB(B0, 0, 0); PG8_LDB(B1, 0, 1); PG8_SCHED; PG8_LDA(At, 0, 0); PG8_STAGE(PG8_SA(1, 1), a1 + hstep, voffA);
            PG8_WAIT_V(8); PG8_WAIT_L(0); PG8_BAR; PG8_MMA(0, 0, At, B0); PG8_MMA(0, 1, At, B1); PG8_BAR; PG8_SCHED;
            PG8_LDA(At, 0, 1); PG8_STAGE(PG8_SB(0, 0), b2, voffB); PG8_STAGE(PG8_SB(0, 1), b2 + hstep, voffB); PG8_STAGE(PG8_SA(0, 0), a2, voffA);
            PG8_WAIT_V(8); PG8_WAIT_L(0); PG8_BAR; PG8_MMA(1, 0, At, B0); PG8_MMA(1, 1, At, B1); PG8_BAR; PG8_SCHED;
            PG8_LDB(B0, 1, 0); PG8_LDB(B1, 1, 1); PG8_SCHED; PG8_LDA(At, 1, 0); PG8_STAGE(PG8_SA(0, 1), a2 + hstep, voffA);
            PG8_WAIT_V(8); PG8_WAIT_L(0); PG8_BAR; PG8_MMA(0, 0, At, B0); PG8_MMA(0, 1, At, B1); PG8_BAR; PG8_SCHED;
            PG8_LDA(At, 1, 1); PG8_STAGE(PG8_SB(1, 0), b3, voffB); PG8_STAGE(PG8_SB(1, 1), b3 + hstep, voffB); PG8_STAGE(PG8_SA(1, 0), a3, voffA);
            PG8_WAIT_V(8); PG8_WAIT_L(0); PG8_BAR; PG8_MMA(1, 0, At, B0); PG8_MMA(1, 1, At, B1); PG8_BAR; PG8_SCHED;
            } else {
            PG8_LDB(B0, 0, 0); PG8_SCHED; PG8_LDA(At, 0, 0); PG8_STAGE(PG8_SA(1, 1), a1 + hstep, voffA);
            PG8_WAIT_L(8); PG8_BAR; PG8_WAIT_L(0); PG8_MMA(0, 0, At, B0); PG8_BAR; PG8_SCHED;
            PG8_LDB(B1, 0, 1); PG8_STAGE(PG8_SB(0, 0), b2, voffB);
            PG8_BAR; PG8_WAIT_L(0); PG8_MMA(0, 1, At, B1); PG8_BAR;
            PG8_LDA(At, 0, 1); PG8_STAGE(PG8_SA(0, 0), a2, voffA);
            PG8_BAR; PG8_WAIT_L(0); PG8_MMA(1, 0, At, B0); PG8_BAR; PG8_SCHED;
            PG8_STAGE(PG8_SB(0, 1), b2 + hstep, voffB);
            PG8_WAIT_V(6); PG8_BAR; PG8_MMA(1, 1, At, B1); PG8_BAR;
            PG8_LDB(B0, 1, 0); PG8_SCHED; PG8_LDA(At, 1, 0); PG8_STAGE(PG8_SA(0, 1), a2 + hstep, voffA);
            PG8_WAIT_L(8); PG8_BAR; PG8_WAIT_L(0); PG8_MMA(0, 0, At, B0); PG8_BAR; PG8_SCHED;
            PG8_LDB(B1, 1, 1); PG8_STAGE(PG8_SB(1, 0), b3, voffB);
            PG8_BAR; PG8_WAIT_L(0); PG8_MMA(0, 1, At, B1); PG8_BAR;
            PG8_LDA(At, 1, 1); PG8_STAGE(PG8_SA(1, 0), a3, voffA);
            PG8_BAR; PG8_WAIT_L(0); PG8_MMA(1, 0, At, B0); PG8_BAR; PG8_SCHED;
            PG8_STAGE(PG8_SB(1, 1), b3 + hstep, voffB);
            PG8_WAIT_V(6); PG8_BAR; PG8_MMA(1, 1, At, B1); PG8_BAR;
            }
        }
        if constexpr (ALIGN_EPI) { if (wr == 0) PG8_BAR; }
        if constexpr (!Epi::AFTER_DRAIN) { E(acc, cur, wr, wc, fr, fq); S.done(cur); }
        if (!has_next) break;
#pragma unroll
        for (int a = 0; a < 2; ++a)
#pragma unroll
            for (int b = 0; b < 2; ++b)
#pragma unroll
                for (int m = 0; m < 4; ++m)
#pragma unroll
                    for (int n = 0; n < 2; ++n) acc[a][b][m][n] = (f32x4){0.f, 0.f, 0.f, 0.f};
        cur = nxt; cA = nA; cB = nB; ++ui;
        if constexpr (ALIGN_EPI) { if (wr == 1) PG8_BAR; }
    }
    PG8_WAIT_V(0);
    if constexpr (!ALIGN_EPI) { if (wr == 0) PG8_BAR; }
    PG8_BAR;
    if constexpr (Epi::AFTER_DRAIN) { E.fused(acc, cur, wr, wc, fr, fq, lds, wid, lane); S.done(cur); }
#undef PG8_SA
#undef PG8_SB
#undef PG8_STAGE
#undef PG8_LDA
#undef PG8_LDB
#undef PG8_MMA
#undef PG8_WAIT_V
#undef PG8_WAIT_L
#undef PG8_BAR
#undef PG8_SCHED
}
}

#ifndef REP_MASK
#define REP_MASK 0
#endif
#ifndef SYNC_REP
#define SYNC_REP 1
#endif
#define GAS __attribute__((address_space(1)))
#define LAS __attribute__((address_space(3)))
#define DI __device__ __forceinline__
typedef unsigned short bf16;
typedef unsigned v4u __attribute__((ext_vector_type(4)));
typedef unsigned v2u __attribute__((ext_vector_type(2)));
typedef float f32x4 __attribute__((ext_vector_type(4)));
typedef float f32x16 __attribute__((ext_vector_type(16)));
typedef short bf16x8 __attribute__((ext_vector_type(8)));
typedef short s16x4 __attribute__((ext_vector_type(4)));
#define MFMA32(a, b, c) __builtin_amdgcn_mfma_f32_32x32x16_bf16((a), (b), (c), 0, 0, 0)

constexpr int NWAVES = 8, NTHR = 512;
constexpr int BATCH = 4, SEQ = 4096, D = 1024, M = BATCH * SEQ, FF = 4096;
constexpr int NIN = 3072, NQKV = 1536, NRET = 1536;
constexpr float EPS = 1e-6f;
constexpr float LOG2E = 1.4426950408889634f, LN2 = 0.6931471805599453f;
constexpr float QSCALE = 0.125f * LOG2E;

constexpr size_t MiB = 1u << 20;
constexpr size_t WS_BAR = 512 * 1024, WS_GRP = WS_BAR + 16384, WS_BAR_BYTES = 32768, WS_XID = WS_BAR + 32768;
constexpr size_t WS_SS = 0;
constexpr size_t WS_WIN = 1 * MiB, WS_WOUT = 7 * MiB, WS_UP0 = 9 * MiB, WS_UP1 = 17 * MiB, WS_DN0 = 25 * MiB, WS_DN1 = 33 * MiB, WS_QKV = 41 * MiB, WS_SWO = 44 * MiB;
constexpr size_t WS_ROPER = 46 * MiB, WS_ROPED = 50 * MiB, WS_LSE = 51 * MiB;
constexpr size_t WS_XA = 53 * MiB;
constexpr size_t WS_PROJ = 85 * MiB;
constexpr size_t WS_DIL = 133 * MiB;
constexpr size_t WS_XB = 85 * MiB;
constexpr size_t WS_HID = 117 * MiB;
constexpr size_t WS_AO = WS_XA;
constexpr size_t WS_OP = 181 * MiB;
constexpr size_t WS_SB = 229 * MiB;
constexpr size_t WS_END = 245 * MiB;
constexpr int LDS_BYTES = 147456;

DI unsigned pk2(float lo, float hi) { return pg8::cvt_pk_bf16(lo, hi); }
DI float bf_lo(unsigned u) { return __uint_as_float(u << 16); }
DI float bf_hi(unsigned u) { return __uint_as_float(u & 0xffff0000u); }
DI int crow(int i, int h) { return (i & 3) + 8 * (i >> 2) + 4 * h; }
DI bf16x8 pack8(const f32x16& x, int s) {
    v4u p; p.x = pk2(x[8 * s], x[8 * s + 1]); p.y = pk2(x[8 * s + 2], x[8 * s + 3]); p.z = pk2(x[8 * s + 4], x[8 * s + 5]); p.w = pk2(x[8 * s + 6], x[8 * s + 7]);
    return __builtin_bit_cast(bf16x8, p);
}
DI bf16x8 cat4(s16x4 lo, s16x4 hi) { return __builtin_shufflevector(lo, hi, 0, 1, 2, 3, 4, 5, 6, 7); }
DI unsigned lds_addr(const LAS void* p) { return (unsigned)(uintptr_t)p; }
#define TR4(r0, r1, r2, r3, ad0, ad1) asm volatile("ds_read_b64_tr_b16 %0, %4\n\tds_read_b64_tr_b16 %1, %4 offset:512\n\tds_read_b64_tr_b16 %2, %5\n\tds_read_b64_tr_b16 %3, %5 offset:512\n\ts_waitcnt lgkmcnt(0)" \
    : "=&v"(r0), "=&v"(r1), "=&v"(r2), "=&v"(r3) : "v"(ad0), "v"(ad1) : "memory")
#define TR4N(r0, r1, r2, r3, ad0, ad1) asm volatile("ds_read_b64_tr_b16 %0, %4\n\tds_read_b64_tr_b16 %1, %4 offset:256\n\tds_read_b64_tr_b16 %2, %5\n\tds_read_b64_tr_b16 %3, %5 offset:256\n\ts_waitcnt lgkmcnt(0)" \
    : "=&v"(r0), "=&v"(r1), "=&v"(r2), "=&v"(r3) : "v"(ad0), "v"(ad1) : "memory")

template <int ACT, bool BIAS> struct EpiRowScale {
    static constexpr bool PERM = true, AFTER_DRAIN = false;
    bf16* O; int ldc; const float* ss; const float* bias;
    __device__ __forceinline__ void operator()(const pg8::f32x4 (&acc)[2][2][4][2], const pg8::Unit& u, int wr, int wc, int fr, int fq) const {
        const int row0 = u.pm * 256 + wr * 64 + fr, col0 = u.pn * 256 + wc * 32 + 8 * fq;
        f32x4 bv[2][2];
#pragma unroll
        for (int bj = 0; bj < 2; ++bj)
#pragma unroll
            for (int n = 0; n < 2; ++n) bv[bj][n] = BIAS ? *(const f32x4*)(bias + col0 + bj * 128 + 4 * n) : (f32x4){0.f, 0.f, 0.f, 0.f};
        float rs[2][4];
#pragma unroll
        for (int ai = 0; ai < 2; ++ai)
#pragma unroll
            for (int m = 0; m < 4; ++m) rs[ai][m] = ss[row0 + ai * 128 + m * 16];
#pragma unroll
        for (int ai = 0; ai < 2; ++ai)
#pragma unroll
            for (int m = 0; m < 4; ++m) {
                const int row = row0 + ai * 128 + m * 16;
                const float s = 1.0f / sqrtf(rs[ai][m] * (1.0f / 1024.0f) + EPS);
                bf16* rowp = O + (size_t)row * ldc + col0;
#pragma unroll
                for (int bj = 0; bj < 2; ++bj) {
                    f32x4 v0 = acc[ai][bj][m][0] * s + bv[bj][0], v1 = acc[ai][bj][m][1] * s + bv[bj][1];
                    if (ACT == 1) {
#pragma unroll
                        for (int e = 0; e < 4; ++e) { const float a = fmaxf(v0[e], 0.f), b = fmaxf(v1[e], 0.f); v0[e] = a * a; v1[e] = b * b; }
                    }
                    v4u w; w.x = pk2(v0[0], v0[1]); w.y = pk2(v0[2], v0[3]); w.z = pk2(v1[0], v1[1]); w.w = pk2(v1[2], v1[3]);
                    *(v4u*)(rowp + bj * 128) = w;
                }
            }
    }
};

template <int LAYER> struct EpiProj {
    static constexpr bool PERM = true, AFTER_DRAIN = false;
    bf16* O; const float* ss; const float* bias; const float* ropeR; const float* ropeD; const float* qg; const float* kg; bf16* Odil;
    __device__ __forceinline__ void operator()(const pg8::f32x4 (&acc)[2][2][4][2], const pg8::Unit& u, int wr, int wc, int fr, int fq) const {
        constexpr int LDC = LAYER == 0 ? NIN : NQKV;
        const int slot = 4 * u.pn + wc;
        int type = 0; float sc = 1.0f; const float* gain = qg;
        if (LAYER == 0) { if (slot < 8) { type = 1; sc = slot >= 4 ? 0.125f : 1.0f; } else if (slot >= 24 && slot < 40) { type = 2; if (slot < 32) sc = QSCALE; else gain = kg; } }
        else { if (slot < 20) { type = 2; if (slot < 16) sc = QSCALE; else gain = kg; } }
        const int row0 = u.pm * 256 + wr * 64 + fr, d0 = 8 * fq;
        f32x4 bv[2][2], gv[2][2];
#pragma unroll
        for (int bj = 0; bj < 2; ++bj)
#pragma unroll
            for (int n = 0; n < 2; ++n) {
                bv[bj][n] = (LAYER == 1) ? *(const f32x4*)(bias + 64 * slot + 32 * bj + d0 + 4 * n) : (f32x4){0.f, 0.f, 0.f, 0.f};
                gv[bj][n] = (type == 2) ? *(const f32x4*)(gain + 32 * bj + d0 + 4 * n) : (f32x4){1.f, 1.f, 1.f, 1.f};
            }
#pragma unroll
        for (int aim = 0; aim < 4; ++aim) {
            float rs[2]; f32x4 cc[2][2], sn[2][2];
#pragma unroll
            for (int mm = 0; mm < 2; ++mm) {
                const int row = row0 + (aim >> 1) * 128 + (2 * (aim & 1) + mm) * 16;
                rs[mm] = ss[row];
#pragma unroll
                for (int n = 0; n < 2; ++n) {
                    if (type == 1) { cc[mm][n] = *(const f32x4*)(ropeR + (size_t)row * 64 + d0 + 4 * n); sn[mm][n] = *(const f32x4*)(ropeR + (size_t)row * 64 + 32 + d0 + 4 * n); }
                    else if (type == 2) { cc[mm][n] = *(const f32x4*)(ropeD + (size_t)row * 16 + 4 * n); sn[mm][n] = *(const f32x4*)(ropeD + (size_t)row * 16 + 8 + 4 * n); }
                    else { cc[mm][n] = (f32x4){1.f, 1.f, 1.f, 1.f}; sn[mm][n] = (f32x4){0.f, 0.f, 0.f, 0.f}; }
                }
            }
#pragma unroll
            for (int mm = 0; mm < 2; ++mm) {
                const int ai = aim >> 1, m = 2 * (aim & 1) + mm;
                const int row = row0 + ai * 128 + m * 16;
                const float s = 1.0f / sqrtf(rs[mm] * (1.0f / 1024.0f) + EPS);
                f32x4 v[2][2];
#pragma unroll
                for (int bj = 0; bj < 2; ++bj)
#pragma unroll
                    for (int n = 0; n < 2; ++n) v[bj][n] = acc[ai][bj][m][n] * s + bv[bj][n];
                if (type == 1) {
#pragma unroll
                    for (int n = 0; n < 2; ++n) {
                        const f32x4 c4 = cc[mm][n], s4 = sn[mm][n];
                        const f32x4 x1 = v[0][n], x2 = v[1][n];
                        v[0][n] = (x1 * c4 - x2 * s4) * sc; v[1][n] = (x2 * c4 + x1 * s4) * sc;
                    }
                } else if (type == 2) {
                    float q = 0.f;
#pragma unroll
                    for (int bj = 0; bj < 2; ++bj)
#pragma unroll
                        for (int n = 0; n < 2; ++n) q += (v[bj][n][0] * v[bj][n][0] + v[bj][n][1] * v[bj][n][1]) + (v[bj][n][2] * v[bj][n][2] + v[bj][n][3] * v[bj][n][3]);
                    q += __shfl_xor(q, 16); q += __shfl_xor(q, 32);
                    const float r = 1.0f / sqrtf(q * (1.0f / 64.0f) + EPS);
#pragma unroll
                    for (int bj = 0; bj < 2; ++bj)
#pragma unroll
                        for (int n = 0; n < 2; ++n) v[bj][n] = v[bj][n] * r * gv[bj][n];
#pragma unroll
                    for (int n = 0; n < 2; ++n) {
                        const f32x4 c4 = cc[mm][n], s4 = sn[mm][n];
#pragma unroll
                        for (int e = 0; e < 4; ++e) {
                            const float own = v[0][n][e], other = __shfl_xor(own, 16);
                            const float rot = (fq == 0) ? (own * c4[e] - other * s4[e]) : (own * c4[e] + other * s4[e]);
                            v[0][n][e] = (fq < 2) ? rot : own;
                        }
                    }
#pragma unroll
                    for (int bj = 0; bj < 2; ++bj)
#pragma unroll
                        for (int n = 0; n < 2; ++n) v[bj][n] = v[bj][n] * sc;
                }
                bf16* rowp;
                if (LAYER == 0) {
                    if (slot < 24) rowp = O + (size_t)row * NRET + 64 * slot + d0;
                    else { const int which = (slot - 24) >> 3, hh = (slot - 24) & 7;
                           rowp = Odil + ((((size_t)which * BATCH + (row >> 12)) * 8 + hh) * SEQ + (row & (SEQ - 1))) * 64 + d0; }
                } else rowp = O + (size_t)row * LDC + 64 * slot + d0;
#pragma unroll
                for (int bj = 0; bj < 2; ++bj) {
                    v4u w; w.x = pk2(v[bj][0][0], v[bj][0][1]); w.y = pk2(v[bj][0][2], v[bj][0][3]); w.z = pk2(v[bj][1][0], v[bj][1][1]); w.w = pk2(v[bj][1][2], v[bj][1][3]);
                    *(v4u*)(rowp + 32 * bj) = w;
                }
            }
        }
    }
};
template <bool BASEB, bool WF32, bool LAST> struct EpiResid {
    static constexpr bool PERM = true, AFTER_DRAIN = false;
    const float* base; const bf16* baseb; float* out; bf16* xb; float* ss; int dry; int pmsh;
    const unsigned* wcnt; unsigned wtarget;
    __device__ __forceinline__ void operator()(const pg8::f32x4 (&acc)[2][2][4][2], const pg8::Unit& u, int wr, int wc, int fr, int fq) const {
        const int row0 = (u.pm >> pmsh) * 256 + wr * 64 + fr, col0 = u.pn * 256 + wc * 32 + 8 * fq;
        if (dry) return;
        if (wcnt) { unsigned sp = 0u; while (__hip_atomic_load(wcnt, __ATOMIC_RELAXED, __HIP_MEMORY_SCOPE_AGENT) < wtarget) { __builtin_amdgcn_s_sleep(1); if (++sp > (1u << 22)) break; } }
#pragma unroll
        for (int ai = 0; ai < 2; ++ai) {
            f32x4 bs[4][2][2];
#pragma unroll
            for (int m = 0; m < 4; ++m) { const size_t off = (size_t)(row0 + ai * 128 + m * 16) * D + col0;
#pragma unroll
                for (int bj = 0; bj < 2; ++bj) {
                    if (BASEB) { const v4u r = *(const v4u*)(baseb + off + bj * 128);
                        bs[m][bj][0] = (f32x4){bf_lo(r.x), bf_hi(r.x), bf_lo(r.y), bf_hi(r.y)}; bs[m][bj][1] = (f32x4){bf_lo(r.z), bf_hi(r.z), bf_lo(r.w), bf_hi(r.w)}; }
                    else { bs[m][bj][0] = *(const f32x4*)(base + off + bj * 128); bs[m][bj][1] = *(const f32x4*)(base + off + bj * 128 + 4); } } }
#pragma unroll
            for (int m = 0; m < 4; ++m) {
                const int row = row0 + ai * 128 + m * 16;
                const size_t off = (size_t)row * D + col0;
                float part = 0.f;
#pragma unroll
                for (int bj = 0; bj < 2; ++bj) {
                    const f32x4 v0 = bs[m][bj][0] + acc[ai][bj][m][0], v1 = bs[m][bj][1] + acc[ai][bj][m][1];
                    if (WF32) { *(f32x4*)(out + off + bj * 128) = v0; *(f32x4*)(out + off + bj * 128 + 4) = v1; }
                    if (!LAST) {
                        v4u w; w.x = pk2(v0[0], v0[1]); w.y = pk2(v0[2], v0[3]); w.z = pk2(v1[0], v1[1]); w.w = pk2(v1[2], v1[3]);
                        *(v4u*)(xb + off + bj * 128) = w;
                        part += (v0[0] * v0[0] + v0[1] * v0[1]) + (v0[2] * v0[2] + v0[3] * v0[3]) + (v1[0] * v1[0] + v1[1] * v1[1]) + (v1[2] * v1[2] + v1[3] * v1[3]);
                    }
                }
                if (!LAST) {
                    part += __shfl_xor(part, 16); part += __shfl_xor(part, 32);
                    if (fq == 0) atomicAdd(ss + row, part);
                }
            }
        }
    }
};

DI float wave_sum(float v) {
#pragma unroll
    for (int o = 1; o < 64; o <<= 1) v += __shfl_xor(v, o);
    return v;
}
DI void p0_transpose_item(const float* W, int K, int N, bf16* WT, const float* gain, LAS float* scr, int item, int lane, bool perm = false) {
    const int nblk = N / 32, kb = item / nblk, nb = item % nblk, k0 = 64 * kb, n0 = 32 * nb;
    float t[32], gg[32];
#pragma unroll
    for (int i = 0; i < 32; ++i) { const int kk = 2 * i + (lane >> 5); t[i] = W[(size_t)(k0 + kk) * N + n0 + (lane & 31)]; gg[i] = gain ? gain[k0 + kk] : 1.0f; }
#pragma unroll
    for (int i = 0; i < 32; ++i) { const int kk = 2 * i + (lane >> 5); scr[kk * 33 + (lane & 31)] = t[i] * gg[i]; }
    asm volatile("s_waitcnt lgkmcnt(0)" ::: "memory");
    const int c = lane & 7;
#pragma unroll
    for (int j = 0; j < 4; ++j) { const int n = (lane >> 3) + 8 * j; const LAS float* s = scr + (8 * c) * 33 + n;
        v4u o; o.x = pk2(s[0 * 33], s[1 * 33]); o.y = pk2(s[2 * 33], s[3 * 33]); o.z = pk2(s[4 * 33], s[5 * 33]); o.w = pk2(s[6 * 33], s[7 * 33]);
        const int real = n0 + n, rowi = perm ? ((real & ~255) + 128 * ((real >> 5) & 1) + 32 * ((real >> 6) & 3) + (real & 31)) : real;
        *(v4u*)(WT + (size_t)rowi * K + k0 + 8 * c) = o; }
    asm volatile("s_waitcnt lgkmcnt(0)" ::: "memory");
}

struct Ptrs {
    const float *x, *norm_mix, *norm_mlp, *w_up, *w_down, *w_in, *w_out, *gn_gain, *dq_gain, *dk_gain, *w_qkv, *b_qkv, *swa_w_out, *sq_gain, *sk_gain, *sinks;
    const int* pos;
    float* out; unsigned char* ws;
};

DI void p0_prologue(const Ptrs& P, LAS unsigned char* lds, int wave, int lane) {
    LAS float* scr = (LAS float*)(lds + wave * 16384);
    const int gw = blockIdx.x * NWAVES + wave, NGW = gridDim.x * NWAVES;
    unsigned char* ws = P.ws;
    constexpr int I_IN = 16 * 96, I_OUT = 16 * 32, I_UP = 16 * 128, I_DN = 64 * 32, I_QKV = 16 * 48;
    constexpr int NITEMS = I_IN + I_OUT + I_UP + I_DN + I_QKV;
    for (int it = gw; it < NITEMS; it += NGW) {
        int r = it;
        if (r < I_IN) { p0_transpose_item(P.w_in, D, NIN, (bf16*)(ws + WS_WIN), P.norm_mix, scr, r, lane, true); continue; } r -= I_IN;
        if (r < I_OUT) { p0_transpose_item(P.w_out, D, D, (bf16*)(ws + WS_WOUT), nullptr, scr, r, lane); continue; } r -= I_OUT;
        if (r < I_UP) { p0_transpose_item(P.w_up, D, FF, (bf16*)(ws + WS_UP0), P.norm_mlp, scr, r, lane); continue; } r -= I_UP;
        if (r < I_DN) { p0_transpose_item(P.w_down, FF, D, (bf16*)(ws + WS_DN0), nullptr, scr, r, lane); continue; } r -= I_DN;
        p0_transpose_item(P.w_qkv, D, NQKV, (bf16*)(ws + WS_QKV), P.norm_mix + D, scr, r, lane, true);
    }
    float* ss = (float*)(ws + WS_SS);
    bf16* xa = (bf16*)(ws + WS_XA);
    for (int m = gw; m < M; m += NGW) {
        const f32x4* xr = (const f32x4*)(P.x + (size_t)m * D) + lane;
        f32x4 v[4]; float s = 0.f;
#pragma unroll
        for (int j = 0; j < 4; ++j) { v[j] = xr[64 * j]; s += (v[j].x * v[j].x + v[j].y * v[j].y) + (v[j].z * v[j].z + v[j].w * v[j].w); }
        s = wave_sum(s);
        v2u* o8 = (v2u*)(xa + (size_t)m * D) + lane;
#pragma unroll
        for (int j = 0; j < 4; ++j) { v2u w; w.x = pk2(v[j].x, v[j].y); w.y = pk2(v[j].z, v[j].w); o8[64 * j] = w; }
        if (lane == 0) ss[m] = s;
    }
    const int gt = blockIdx.x * NTHR + threadIdx.x, NGT = gridDim.x * NTHR;
    for (int i = gt; i < 3 * M; i += NGT) ss[M + i] = 0.f;
    float* ropeR = (float*)(ws + WS_ROPER); float* ropeD = (float*)(ws + WS_ROPED);
    for (int i = gt; i < M * 40; i += NGT) {
        const int m = i / 40, a = i % 40;
        const float pos = (float)P.pos[m];
        float inv;
        { const double arg = (a < 32) ? -(double)a * (13.287712379549449 / 32.0) : -(double)(a - 32) * (18.931568569324174 / 8.0);
          const double nf = floor(arg); inv = __builtin_ldexpf(__builtin_amdgcn_exp2f((float)(arg - nf)), (int)nf); }
        const float ang = pos * inv;
        const double rev = (double)ang * 0.15915494309189535;
        const float fr = (float)(rev - rint(rev));
        const float c = __builtin_amdgcn_cosf(fr), s = __builtin_amdgcn_sinf(fr);
        if (a < 32) { ropeR[(size_t)m * 64 + a] = c; ropeR[(size_t)m * 64 + 32 + a] = s; }
        else { ropeD[(size_t)m * 16 + (a - 32)] = c; ropeD[(size_t)m * 16 + 8 + (a - 32)] = s; }
    }
}


DI void p0_late(const Ptrs& P, LAS unsigned char* lds, int wave, int lane, int first) {
    LAS float* scr = (LAS float*)(lds + wave * 16384);
    const int nw = ((int)gridDim.x - first) * NWAVES, gw = ((int)blockIdx.x - first) * NWAVES + wave;
    constexpr int I_UP = 16 * 128, I_OUT = 16 * 32, I_DN = 64 * 32;
    for (int it = gw; it < I_UP + I_OUT + I_DN; it += nw) {
        if (it < I_UP) p0_transpose_item(P.w_up + (size_t)D * FF, D, FF, (bf16*)(P.ws + WS_UP1), P.norm_mlp + D, scr, it, lane);
        else if (it < I_UP + I_OUT) p0_transpose_item(P.swa_w_out, D, D, (bf16*)(P.ws + WS_SWO), nullptr, scr, it - I_UP, lane);
        else p0_transpose_item(P.w_down + (size_t)D * FF, FF, D, (bf16*)(P.ws + WS_DN1), nullptr, scr, it - I_UP - I_OUT, lane);
    }
}

DI void load64(const bf16* p, float (&v)[64]) {
#pragma unroll
    for (int c = 0; c < 8; ++c) { const v4u u = ((const v4u*)p)[c];
        v[8 * c + 0] = bf_lo(u.x); v[8 * c + 1] = bf_hi(u.x); v[8 * c + 2] = bf_lo(u.y); v[8 * c + 3] = bf_hi(u.y);
        v[8 * c + 4] = bf_lo(u.z); v[8 * c + 5] = bf_hi(u.z); v[8 * c + 6] = bf_lo(u.w); v[8 * c + 7] = bf_hi(u.w); }
}
DI void store64(bf16* p, const float (&v)[64]) {
#pragma unroll
    for (int c = 0; c < 8; ++c) { v4u u; u.x = pk2(v[8 * c], v[8 * c + 1]); u.y = pk2(v[8 * c + 2], v[8 * c + 3]); u.z = pk2(v[8 * c + 4], v[8 * c + 5]); u.w = pk2(v[8 * c + 6], v[8 * c + 7]); ((v4u*)p)[c] = u; }
}
DI void ret_rope(bf16* p, bf16* dstp, const float* t, float sc) {
    float v[64]; load64(p, v);
#pragma unroll
    for (int i4 = 0; i4 < 8; ++i4) { const f32x4 c4 = ((const f32x4*)t)[i4], s4 = ((const f32x4*)t)[8 + i4];
#pragma unroll
        for (int e = 0; e < 4; ++e) { const int i = 4 * i4 + e; const float x1 = v[i], x2 = v[i + 32]; v[i] = (x1 * c4[e] - x2 * s4[e]) * sc; v[i + 32] = (x2 * c4[e] + x1 * s4[e]) * sc; } }
    store64(dstp, v);
}
DI void norm_rope(bf16* p, bf16* dstp, const float* t, const float* g, float sc) {
    float v[64]; load64(p, v);
    float ss = 0.f;
#pragma unroll
    for (int i = 0; i < 64; ++i) ss += v[i] * v[i];
    const float r = 1.0f / sqrtf(ss * (1.0f / 64.0f) + EPS);
#pragma unroll
    for (int i4 = 0; i4 < 16; ++i4) { const f32x4 g4 = ((const f32x4*)g)[i4];
#pragma unroll
        for (int e = 0; e < 4; ++e) v[4 * i4 + e] = v[4 * i4 + e] * r * g4[e]; }
#pragma unroll
    for (int i4 = 0; i4 < 2; ++i4) { const f32x4 c4 = ((const f32x4*)t)[i4], s4 = ((const f32x4*)t)[2 + i4];
#pragma unroll
        for (int e = 0; e < 4; ++e) { const int i = 4 * i4 + e; const float x1 = v[i], x2 = v[i + 8]; v[i] = x1 * c4[e] - x2 * s4[e]; v[i + 8] = x2 * c4[e] + x1 * s4[e]; } }
#pragma unroll
    for (int i = 0; i < 64; ++i) v[i] *= sc;
    store64(dstp, v);
}
DI void post0(const Ptrs& P, bool dry) {
    bf16* junk = (bf16*)(P.ws + WS_OP);
    bf16* proj = (bf16*)(P.ws + WS_PROJ); const float* ropeR = (const float*)(P.ws + WS_ROPER); const float* ropeD = (const float*)(P.ws + WS_ROPED);
    const int gt = blockIdx.x * NTHR + threadIdx.x, NGT = gridDim.x * NTHR;
    for (int it = gt; it < M * 24; it += NGT) {
        const int m = it / 24, slot = it % 24;
        if (slot < 8) ret_rope(proj + (size_t)m * NIN + 64 * slot, dry ? junk + (size_t)it * 64 : proj + (size_t)m * NIN + 64 * slot, ropeR + (size_t)m * 64, slot >= 4 ? 0.125f : 1.0f);
        else norm_rope(proj + (size_t)m * NIN + 1024 + 64 * slot, dry ? junk + (size_t)it * 64 : proj + (size_t)m * NIN + 1024 + 64 * slot, ropeD + (size_t)m * 16, slot < 16 ? P.dq_gain : P.dk_gain, slot < 16 ? QSCALE : 1.0f);
    }
}
DI void post1(const Ptrs& P, bool dry) {
    bf16* junk = (bf16*)(P.ws + WS_OP);
    bf16* proj = (bf16*)(P.ws + WS_PROJ); const float* ropeD = (const float*)(P.ws + WS_ROPED);
    const int gt = blockIdx.x * NTHR + threadIdx.x, NGT = gridDim.x * NTHR;
    for (int it = gt; it < M * 20; it += NGT) {
        const int m = it / 20, slot = it % 20;
        norm_rope(proj + (size_t)m * NQKV + 64 * slot, dry ? junk + (size_t)it * 64 : proj + (size_t)m * NQKV + 64 * slot, ropeD + (size_t)m * 16, slot < 16 ? P.sq_gain : P.sk_gain, slot < 16 ? QSCALE : 1.0f);
    }
}

template <bool STRICT0, bool SINK>
DI void banded_wave(const bf16x8 (&qf)[4], const LAS unsigned char* kb, unsigned vaddr, unsigned vh, int jlo, float sinkv, int n, int hl, f32x16 (&o)[2], float& m_out, float& den_out) {
    f32x16 st[5];
#pragma unroll
    for (int j = 0; j < 5; ++j) {
        f32x16 c;
#pragma unroll
        for (int i = 0; i < 16; ++i) c[i] = 0.f;
#pragma unroll
        for (int s = 0; s < 4; ++s) { const bf16x8 a = *(const LAS bf16x8*)(kb + (32 * j + n) * 144 + (16 * s + 8 * hl) * 2); c = MFMA32(a, qf[s], c); }
        st[j] = c;
    }
    const float NINF = -__builtin_inff();
    float mx = NINF;
#pragma unroll
    for (int j = 0; j < 5; ++j) {
        const bool dead = j < jlo;
#pragma unroll
        for (int i = 0; i < 16; ++i) {
            const int t = crow(i, hl);
            bool ok = !dead;
            if (j == 0) ok = ok && (STRICT0 ? (t > n) : (t >= n));
            if (j == 4) ok = ok && (t <= n);
            const float v = ok ? st[j][i] : NINF;
            st[j][i] = v; mx = fmaxf(mx, v);
        }
    }
    mx = fmaxf(mx, __shfl_xor(mx, 32));
    if (SINK) mx = fmaxf(mx, sinkv);
    float den = 0.f;
#pragma unroll
    for (int j = 0; j < 5; ++j)
#pragma unroll
        for (int i = 0; i < 16; ++i) { const float p = __builtin_amdgcn_exp2f(st[j][i] - mx); st[j][i] = p; den += p; }
    den += __shfl_xor(den, 32);
    if (SINK) den += __builtin_amdgcn_exp2f(sinkv - mx);
#pragma unroll
    for (int i = 0; i < 16; ++i) { o[0][i] = 0.f; o[1][i] = 0.f; }
#pragma unroll
    for (int j = 0; j < 5; ++j)
#pragma unroll
        for (int s2 = 0; s2 < 2; ++s2) {
            const bf16x8 pf = pack8(st[j], s2);
            s16x4 a0l, a0h, a1l, a1h;
            const unsigned ad = vaddr + (32 * j + 16 * s2) * 64;
            TR4(a0l, a0h, a1l, a1h, ad, ad + vh);
            o[0] = MFMA32(cat4(a0l, a0h), pf, o[0]); o[1] = MFMA32(cat4(a1l, a1h), pf, o[1]);
        }
    m_out = mx; den_out = den;
}

struct DilU { int p, b, h, sh, res, qb; };
DI DilU dil_decode(int u) { DilU d; d.p = u % 3; const int rem = u / 3; d.b = rem >> 7; d.h = (rem >> 4) & 7; const int idx16 = rem & 15; d.sh = 2 * d.p; d.res = idx16 & ((1 << d.sh) - 1); d.qb = idx16 >> d.sh; return d; }
DI void dil_issue(const DilU& d, const bf16* proj, int tid, int wave, int lane, v4u (&kreg)[6], v4u (&vreg)[6], bf16x8 (&qf)[4]) {
    const int l0 = 256 * d.qb; const size_t tokbase = (size_t)d.b * SEQ;
#pragma unroll
    for (int c = 0; c < 6; ++c) {
        const int id = tid + 512 * c, row = id >> 3, ch = id & 7, l = l0 - 128 + row;
        if (l >= 0) { const bf16* src = proj + ((size_t)(d.b * 8 + d.h) * SEQ + ((size_t)l << d.sh) + d.res) * 64 + ch * 8;
            kreg[c] = *(const v4u*)(src + (size_t)1 * BATCH * 8 * SEQ * 64); vreg[c] = *(const v4u*)(src + (size_t)2 * BATCH * 8 * SEQ * 64); }
        else { kreg[c] = (v4u){0u, 0u, 0u, 0u}; vreg[c] = (v4u){0u, 0u, 0u, 0u}; }
    }
    const int ql = l0 + 32 * wave + (lane & 31);
    const bf16* qs = proj + ((size_t)(d.b * 8 + d.h) * SEQ + ((size_t)ql << d.sh) + d.res) * 64 + 8 * (lane >> 5);
#pragma unroll
    for (int s = 0; s < 4; ++s) qf[s] = *(const bf16x8*)(qs + 16 * s);
}
DI void dil_phase(const Ptrs& P, LAS unsigned char* lds, int tid, int wave, int lane) {
    const bf16* proj = (const bf16*)(P.ws + WS_DIL);
    bf16* op = (bf16*)(P.ws + WS_OP); float* lse = (float*)(P.ws + WS_LSE);
    constexpr unsigned KOFF = 0, VOFF = 384 * 144, VH = 384 * 64;
    int u = blockIdx.x; if (u >= 1536) return;
    const int n = lane & 31, hl = lane >> 5;
    const int i16 = lane & 15, q4 = i16 >> 2, p4 = i16 & 3, g16 = (lane >> 4) & 1;
    const unsigned vaddr = lds_addr(lds + VOFF) + (32 * wave + 4 * hl + q4) * 64 + (16 * g16 + 4 * p4) * 2;
    v4u kreg[6], vreg[6]; bf16x8 qn[4];
    DilU d = dil_decode(u);
    dil_issue(d, proj, tid, wave, lane, kreg, vreg, qn);
    for (;;) {
#pragma unroll
        for (int c = 0; c < 6; ++c) {
            const int id = tid + 512 * c, row = id >> 3, ch = id & 7;
            *(LAS v4u*)(lds + KOFF + row * 144 + ch * 16) = kreg[c];
            *(LAS v4u*)(lds + VOFF + (ch >> 2) * VH + row * 64 + (ch & 3) * 16) = vreg[c];
        }
        bf16x8 qf[4];
#pragma unroll
        for (int s = 0; s < 4; ++s) qf[s] = qn[s];
        __syncthreads();
        const int un = u + gridDim.x; const bool more = un < 1536;
        const DilU dn = dil_decode(more ? un : u);
        if (more) dil_issue(dn, proj, tid, wave, lane, kreg, vreg, qn);
        const int jlo = (d.qb == 0) ? max(0, 4 - wave) : 0;
        f32x16 o[2]; float mx, den;
        banded_wave<false, false>(qf, lds + KOFF + (32 * wave) * 144, vaddr, VH, jlo, 0.f, n, hl, o, mx, den);
        const float inv = 1.0f / den;
        const size_t qtok = (size_t)d.b * SEQ + ((size_t)(256 * d.qb + 32 * wave + n) << d.sh) + d.res;
        bf16* dst = op + ((size_t)d.p * M + qtok) * 512 + d.h * 64 + 4 * hl;
#pragma unroll
        for (int mt = 0; mt < 2; ++mt)
#pragma unroll
            for (int g = 0; g < 4; ++g) { v2u w; w.x = pk2(o[mt][4 * g] * inv, o[mt][4 * g + 1] * inv); w.y = pk2(o[mt][4 * g + 2] * inv, o[mt][4 * g + 3] * inv);
                *(v2u*)(dst + 32 * mt + 8 * g) = w; }
        if (hl == 0) lse[((size_t)d.p * M + qtok) * 8 + d.h] = (mx + __builtin_amdgcn_logf(den)) * LN2;
        __syncthreads();
        if (!more) break;
        u = un; d = dn;
    }
}

DI void swa_issue(int u, const bf16* proj, int tid, int wave, int lane, v4u (&kreg)[3], v4u (&vreg)[3], bf16x8 (&qf)[4]) {
    const int b = u >> 8, kvh = (u >> 6) & 3, qblk = u & 63, q0 = 64 * qblk;
    const size_t tokbase = (size_t)b * SEQ;
#pragma unroll
    for (int c = 0; c < 3; ++c) {
        const int id = tid + 512 * c, row = id >> 3, ch = id & 7, t = q0 - 128 + row;
        if (t >= 0) { const bf16* src = proj + (tokbase + t) * NQKV + kvh * 64 + ch * 8;
            kreg[c] = *(const v4u*)(src + 1024); vreg[c] = *(const v4u*)(src + 1280); }
        else { kreg[c] = (v4u){0u, 0u, 0u, 0u}; vreg[c] = (v4u){0u, 0u, 0u, 0u}; }
    }
    const int g = wave >> 1, qh = wave & 1, qhead = kvh * 4 + g;
    const bf16* qs = proj + (tokbase + q0 + 32 * qh + (lane & 31)) * NQKV + qhead * 64 + 8 * (lane >> 5);
#pragma unroll
    for (int s = 0; s < 4; ++s) qf[s] = *(const bf16x8*)(qs + 16 * s);
}
DI void swa_phase(const Ptrs& P, LAS unsigned char* lds, int tid, int wave, int lane, int u0, int ustep, int ucnt) {
    const bf16* proj = (const bf16*)(P.ws + WS_PROJ);
    bf16* ao = (bf16*)P.out;
    constexpr unsigned KOFF = 0, VOFF = 192 * 144, VH = 192 * 64;
    int u = u0, left = ucnt; if (left <= 0) return;
    const int n = lane & 31, hl = lane >> 5, g = wave >> 1, qh = wave & 1;
    const int i16 = lane & 15, q4 = i16 >> 2, p4 = i16 & 3, g16 = (lane >> 4) & 1;
    const unsigned vaddr = lds_addr(lds + VOFF) + (32 * qh + 4 * hl + q4) * 64 + (16 * g16 + 4 * p4) * 2;
    v4u kreg[3], vreg[3]; bf16x8 qn[4];
    swa_issue(u, proj, tid, wave, lane, kreg, vreg, qn);
    for (;;) {
#pragma unroll
        for (int c = 0; c < 3; ++c) {
            const int id = tid + 512 * c, row = id >> 3, ch = id & 7;
            *(LAS v4u*)(lds + KOFF + row * 144 + ch * 16) = kreg[c];
            *(LAS v4u*)(lds + VOFF + (ch >> 2) * VH + row * 64 + (ch & 3) * 16) = vreg[c];
        }
        bf16x8 qf[4];
#pragma unroll
        for (int s = 0; s < 4; ++s) qf[s] = qn[s];
        __syncthreads();
        const int un = u + ustep; --left; const bool more = left > 0;
        if (more) swa_issue(un, proj, tid, wave, lane, kreg, vreg, qn);
        const int b = u >> 8, kvh = (u >> 6) & 3, qblk = u & 63, q0 = 64 * qblk, qhead = kvh * 4 + g;
        const int jlo = max(0, 4 - 2 * qblk - qh);
        const float sinkv = P.sinks[qhead] * LOG2E;
        f32x16 o[2]; float mx, den;
        banded_wave<true, true>(qf, lds + KOFF + (32 * qh) * 144, vaddr, VH, jlo, sinkv, n, hl, o, mx, den);
        const float inv = 1.0f / den;
        const size_t qtok = (size_t)b * SEQ + q0 + 32 * qh + n;
        bf16* dst = ao + (qtok >> 8) * 524288 + (qtok & 255) * D + qhead * 64 + 4 * hl;
#pragma unroll
        for (int mt = 0; mt < 2; ++mt)
#pragma unroll
            for (int gg = 0; gg < 4; ++gg) { v2u w; w.x = pk2(o[mt][4 * gg] * inv, o[mt][4 * gg + 1] * inv); w.y = pk2(o[mt][4 * gg + 2] * inv, o[mt][4 * gg + 3] * inv);
                *(v2u*)(dst + 32 * mt + 8 * gg) = w; }
        __syncthreads();
        if (!more) break;
        u = un;
    }
}

DI float ret_lg2(int h) { return __builtin_amdgcn_logf(1.0f - __builtin_amdgcn_exp2f(-5.0f - (float)h)); }
DI void retA_unit(int u, const Ptrs& P, LAS unsigned char* lds, int tid, int wave, int lane) {
    const bf16* proj = (const bf16*)(P.ws + WS_PROJ);
    bf16* sb = (bf16*)(P.ws + WS_SB) + (size_t)u * 8192;
    const int b = u >> 7, h = (u >> 5) & 3, nck = u & 31;
    const float lg2 = ret_lg2(h);
    const size_t tok0 = (size_t)b * SEQ + nck * 128;
    constexpr unsigned VOFF = 0, KOFF = 32768;
    v4u vreg[4], kreg[2];
#pragma unroll
    for (int c = 0; c < 4; ++c) { const int id = tid + 512 * c, row = id >> 4, ch = id & 15; vreg[c] = *(const v4u*)(proj + (tok0 + row) * NRET + 512 + h * 128 + ch * 8); }
#pragma unroll
    for (int c = 0; c < 2; ++c) { const int id = tid + 512 * c, row = id >> 3, ch = id & 7; kreg[c] = *(const v4u*)(proj + (tok0 + row) * NRET + 256 + h * 64 + ch * 8); }
#pragma unroll
    for (int c = 0; c < 4; ++c) { const int id = tid + 512 * c, row = id >> 4, ch = id & 15; *(LAS v4u*)(lds + VOFF + (ch >> 2) * 8192 + row * 64 + (ch & 3) * 16) = vreg[c]; }
#pragma unroll
    for (int c = 0; c < 2; ++c) { const int id = tid + 512 * c, row = id >> 3, ch = id & 7;
        const float z = __builtin_amdgcn_exp2f((float)(127 - row) * lg2);
        v4u k = kreg[c], w;
        w.x = pk2(bf_lo(k.x) * z, bf_hi(k.x) * z); w.y = pk2(bf_lo(k.y) * z, bf_hi(k.y) * z); w.z = pk2(bf_lo(k.z) * z, bf_hi(k.z) * z); w.w = pk2(bf_lo(k.w) * z, bf_hi(k.w) * z);
        *(LAS v4u*)(lds + KOFF + (ch >> 2) * 8192 + row * 64 + (ch & 3) * 16) = w; }
    __syncthreads();
    const int n = lane & 31, hl = lane >> 5, mt = wave >> 1, nt = wave & 1;
    const int i16 = lane & 15, q4 = i16 >> 2, p4 = i16 & 3, g16 = (lane >> 4) & 1;
    const unsigned lo = (8 * hl + q4) * 64 + (16 * g16 + 4 * p4) * 2;
    const unsigned va = lds_addr(lds + VOFF) + mt * 8192 + lo, ka = lds_addr(lds + KOFF) + nt * 8192 + lo;
    f32x16 acc;
#pragma unroll
    for (int i = 0; i < 16; ++i) acc[i] = 0.f;
#pragma unroll
    for (int s = 0; s < 8; ++s) {
        s16x4 al, ah, bl, bh;
        TR4N(al, ah, bl, bh, va + s * 1024, ka + s * 1024);
        acc = MFMA32(cat4(al, ah), cat4(bl, bh), acc);
    }
#pragma unroll
    for (int i = 0; i < 16; ++i) sb[(32 * mt + crow(i, hl)) * 64 + 32 * nt + n] = (bf16)(pk2(acc[i], 0.f) & 0xffffu);
    __syncthreads();
}

DI void retB_unit(int u, const Ptrs& P, LAS unsigned char* lds, int tid, int wave, int lane, float (&R)[2][8], bool have, bool carry) {
    const bf16* proj = (const bf16*)(P.ws + WS_PROJ);
    bf16* mixed = (bf16*)P.out;
    const int b = u >> 7, h = (u >> 5) & 3, nck = u & 31;
    const float lg2 = ret_lg2(h);
    const size_t tok0 = (size_t)b * SEQ + nck * 128;
    constexpr unsigned KOFF = 0, VOFF = 18432, ROFF = 51200;
    v4u vreg[4], kreg[2];
#pragma unroll
    for (int c = 0; c < 4; ++c) { const int id = tid + 512 * c, row = id >> 4, ch = id & 15; vreg[c] = *(const v4u*)(proj + (tok0 + row) * NRET + 512 + h * 128 + ch * 8); }
#pragma unroll
    for (int c = 0; c < 2; ++c) { const int id = tid + 512 * c, row = id >> 3, ch = id & 7; kreg[c] = *(const v4u*)(proj + (tok0 + row) * NRET + 256 + h * 64 + ch * 8); }
    const int n = lane & 31, hl = lane >> 5, qg = wave >> 1, dvh = wave & 1;
    bf16x8 qf[4];
    { const bf16* qs = proj + (tok0 + 32 * qg + n) * NRET + h * 64 + 8 * hl;
#pragma unroll
      for (int s = 0; s < 4; ++s) qf[s] = *(const bf16x8*)(qs + 16 * s); }
    v4u gate[4];
    { const bf16* gp = proj + (tok0 + (tid >> 2)) * NRET + 1024 + h * 128 + 32 * (tid & 3);
#pragma unroll
      for (int k8 = 0; k8 < 4; ++k8) gate[k8] = ((const v4u*)gp)[k8]; }
    const float cd = __builtin_amdgcn_exp2f(128.0f * lg2);
    v4u own[2];
    if (carry) { const v4u* so = (const v4u*)((const bf16*)(P.ws + WS_SB) + (size_t)u * 8192) + tid; own[0] = so[0]; own[1] = so[512]; }
    if (!have) {
#pragma unroll
        for (int j = 0; j < 2; ++j)
#pragma unroll
            for (int e = 0; e < 8; ++e) R[j][e] = 0.f;
        const v4u* sp = (const v4u*)((const bf16*)(P.ws + WS_SB) + (size_t)(u - nck) * 8192) + tid;
        for (int m0 = 0; m0 < nck; m0 += 8) {
            v4u t[8][2];
#pragma unroll
            for (int q = 0; q < 8; ++q) { const int mm = min(m0 + q, nck - 1);
#pragma unroll
                for (int j = 0; j < 2; ++j) t[q][j] = sp[(size_t)mm * 1024 + 512 * j]; }
#pragma unroll
            for (int q = 0; q < 8; ++q) if (m0 + q < nck) {
#pragma unroll
                for (int j = 0; j < 2; ++j) { const v4u x = t[q][j];
                    R[j][0] = R[j][0] * cd + bf_lo(x.x); R[j][1] = R[j][1] * cd + bf_hi(x.x); R[j][2] = R[j][2] * cd + bf_lo(x.y); R[j][3] = R[j][3] * cd + bf_hi(x.y);
                    R[j][4] = R[j][4] * cd + bf_lo(x.z); R[j][5] = R[j][5] * cd + bf_hi(x.z); R[j][6] = R[j][6] * cd + bf_lo(x.w); R[j][7] = R[j][7] * cd + bf_hi(x.w); } }
        }
    }
#pragma unroll
    for (int j = 0; j < 2; ++j) { const int e = (tid + 512 * j) * 8, dv = e >> 6, dk = e & 63;
        v4u w; w.x = pk2(R[j][0], R[j][1]); w.y = pk2(R[j][2], R[j][3]); w.z = pk2(R[j][4], R[j][5]); w.w = pk2(R[j][6], R[j][7]);
        *(LAS v4u*)(lds + ROFF + dv * 144 + dk * 2) = w; }
    if (carry) {
#pragma unroll
        for (int j = 0; j < 2; ++j) { const v4u x = own[j];
            R[j][0] = R[j][0] * cd + bf_lo(x.x); R[j][1] = R[j][1] * cd + bf_hi(x.x); R[j][2] = R[j][2] * cd + bf_lo(x.y); R[j][3] = R[j][3] * cd + bf_hi(x.y);
            R[j][4] = R[j][4] * cd + bf_lo(x.z); R[j][5] = R[j][5] * cd + bf_hi(x.z); R[j][6] = R[j][6] * cd + bf_lo(x.w); R[j][7] = R[j][7] * cd + bf_hi(x.w); }
    }
#pragma unroll
    for (int c = 0; c < 4; ++c) { const int id = tid + 512 * c, row = id >> 4, ch = id & 15; *(LAS v4u*)(lds + VOFF + (ch >> 2) * 8192 + row * 64 + (ch & 3) * 16) = vreg[c]; }
#pragma unroll
    for (int c = 0; c < 2; ++c) { const int id = tid + 512 * c, row = id >> 3, ch = id & 7; *(LAS v4u*)(lds + KOFF + row * 144 + ch * 16) = kreg[c]; }
    __syncthreads();
    f32x16 o[2];
#pragma unroll
    for (int mt = 0; mt < 2; ++mt) {
        f32x16 c;
#pragma unroll
        for (int i = 0; i < 16; ++i) c[i] = 0.f;
#pragma unroll
        for (int s = 0; s < 4; ++s) { const bf16x8 a = *(const LAS bf16x8*)(lds + ROFF + (64 * dvh + 32 * mt + n) * 144 + (16 * s + 8 * hl) * 2); c = MFMA32(a, qf[s], c); }
        const float xi = __builtin_amdgcn_exp2f((float)(32 * qg + n + 1) * lg2);
#pragma unroll
        for (int i = 0; i < 16; ++i) c[i] *= xi;
        o[mt] = c;
    }
    const int i16 = lane & 15, q4 = i16 >> 2, p4 = i16 & 3, g16 = (lane >> 4) & 1;
    const unsigned vaddr = lds_addr(lds + VOFF) + (2 * dvh) * 8192 + (4 * hl + q4) * 64 + (16 * g16 + 4 * p4) * 2;
    for (int j = 0; j <= qg; ++j) {
        f32x16 st;
#pragma unroll
        for (int i = 0; i < 16; ++i) st[i] = 0.f;
#pragma unroll
        for (int s = 0; s < 4; ++s) { const bf16x8 a = *(const LAS bf16x8*)(lds + KOFF + (32 * j + n) * 144 + (16 * s + 8 * hl) * 2); st = MFMA32(a, qf[s], st); }
#pragma unroll
        for (int i = 0; i < 16; ++i) { const int diff = 32 * (qg - j) + n - crow(i, hl); st[i] = diff >= 0 ? st[i] * __builtin_amdgcn_exp2f((float)diff * lg2) : 0.f; }
#pragma unroll
        for (int s2 = 0; s2 < 2; ++s2) {
            const bf16x8 pf = pack8(st, s2);
            s16x4 a0l, a0h, a1l, a1h;
            const unsigned ad = vaddr + (32 * j + 16 * s2) * 64;
            TR4(a0l, a0h, a1l, a1h, ad, ad + 8192);
            o[0] = MFMA32(cat4(a0l, a0h), pf, o[0]); o[1] = MFMA32(cat4(a1l, a1h), pf, o[1]);
        }
    }
    __syncthreads();
    LAS float* ot = (LAS float*)lds;
#pragma unroll
    for (int mt = 0; mt < 2; ++mt)
#pragma unroll
        for (int i = 0; i < 16; ++i) ot[(32 * qg + n) * 129 + 64 * dvh + 32 * mt + crow(i, hl)] = o[mt][i];
    __syncthreads();
    {
        const int c = tid >> 2, sg = tid & 3;
        float v[32]; float s = 0.f;
#pragma unroll
        for (int k = 0; k < 32; ++k) { v[k] = ot[c * 129 + 32 * sg + k]; s += v[k]; }
        s += __shfl_xor(s, 1); s += __shfl_xor(s, 2);
        const float mu = s * (1.0f / 128.0f);
        float q = 0.f;
#pragma unroll
        for (int k = 0; k < 32; ++k) { v[k] -= mu; q += v[k] * v[k]; }
        q += __shfl_xor(q, 1); q += __shfl_xor(q, 2);
        const float rs = 1.0f / sqrtf(q * (1.0f / 128.0f) + EPS);
        f32x4 gnv[8];
#pragma unroll
        for (int k4 = 0; k4 < 8; ++k4) gnv[k4] = *(const f32x4*)(P.gn_gain + h * 128 + 32 * sg + 4 * k4);
        bf16* dst = mixed + ((tok0 + c) >> 8) * 524288 + ((tok0 + c) & 255) * D + h * 128 + 32 * sg;
#pragma unroll
        for (int k8 = 0; k8 < 4; ++k8) {
            const v4u gu = gate[k8];
            float g[8] = {bf_lo(gu.x), bf_hi(gu.x), bf_lo(gu.y), bf_hi(gu.y), bf_lo(gu.z), bf_hi(gu.z), bf_lo(gu.w), bf_hi(gu.w)};
            float r[8];
#pragma unroll
            for (int e = 0; e < 8; ++e) { const float gate = g[e] / (1.0f + __expf(-g[e])); r[e] = v[8 * k8 + e] * rs * gnv[2 * k8 + (e >> 2)][e & 3] * gate; }
            v4u w; w.x = pk2(r[0], r[1]); w.y = pk2(r[2], r[3]); w.z = pk2(r[4], r[5]); w.w = pk2(r[6], r[7]);
            ((v4u*)dst)[k8] = w;
        }
    }
    __syncthreads();
}
DI void dil_combine(const Ptrs& P, int tokb, int nitems, int gt, int NGT) {
    const bf16* op = (const bf16*)(P.ws + WS_OP); const float* lse = (const float*)(P.ws + WS_LSE); bf16* mixed = (bf16*)P.out;
    for (int it = gt; it < nitems; it += NGT) {
        const int tok = tokb + (it >> 6), hh = (it >> 3) & 7, ch = it & 7;
        const float l0 = lse[((size_t)0 * M + tok) * 8 + hh], l1 = lse[((size_t)1 * M + tok) * 8 + hh], l2 = lse[((size_t)2 * M + tok) * 8 + hh];
        const float mx = fmaxf(l0, fmaxf(l1, l2));
        float w0 = __expf(l0 - mx), w1 = __expf(l1 - mx), w2 = __expf(l2 - mx);
        const float inv = 1.0f / (w0 + w1 + w2); w0 *= inv; w1 *= inv; w2 *= inv;
        const v4u a = *(const v4u*)(op + ((size_t)0 * M + tok) * 512 + hh * 64 + ch * 8);
        const v4u bb = *(const v4u*)(op + ((size_t)1 * M + tok) * 512 + hh * 64 + ch * 8);
        const v4u c = *(const v4u*)(op + ((size_t)2 * M + tok) * 512 + hh * 64 + ch * 8);
        v4u w;
        w.x = pk2(w0 * bf_lo(a.x) + w1 * bf_lo(bb.x) + w2 * bf_lo(c.x), w0 * bf_hi(a.x) + w1 * bf_hi(bb.x) + w2 * bf_hi(c.x));
        w.y = pk2(w0 * bf_lo(a.y) + w1 * bf_lo(bb.y) + w2 * bf_lo(c.y), w0 * bf_hi(a.y) + w1 * bf_hi(bb.y) + w2 * bf_hi(c.y));
        w.z = pk2(w0 * bf_lo(a.z) + w1 * bf_lo(bb.z) + w2 * bf_lo(c.z), w0 * bf_hi(a.z) + w1 * bf_hi(bb.z) + w2 * bf_hi(c.z));
        w.w = pk2(w0 * bf_lo(a.w) + w1 * bf_lo(bb.w) + w2 * bf_lo(c.w), w0 * bf_hi(a.w) + w1 * bf_hi(bb.w) + w2 * bf_hi(c.w));
        *(v4u*)(mixed + (size_t)(tok >> 8) * 524288 + (size_t)(tok & 255) * D + 512 + hh * 64 + ch * 8) = w;
    }
}

#define XB_TMO      128
#define XB_XCNT(j)  (256  + 64 * (j))
#define XB_XSUB(j)  (1280 + 64 * (j))
#define XB_XGEN(j)  (2304 + 64 * (j))
#define XB_TOP      3328
#define XB_TOPGEN   3392
#define XCD_BAR_WORDS 3456
#define XB_SPIN_CAP (1u << 18)

__device__ __forceinline__ unsigned xb_ld(unsigned* p)              { return __hip_atomic_load(p, __ATOMIC_RELAXED, __HIP_MEMORY_SCOPE_AGENT); }
__device__ __forceinline__ unsigned xb_add(unsigned* p, unsigned v) { return __hip_atomic_fetch_add(p, v, __ATOMIC_RELAXED, __HIP_MEMORY_SCOPE_AGENT); }
__device__ __forceinline__ unsigned xb_xcc_id() { return (unsigned)__builtin_amdgcn_s_getreg((3 << 11) | 20) & 0xFu; }
#define XB_SPIN(cond, bar) do { unsigned _sp = 0; while (cond) { __builtin_amdgcn_s_sleep(1); \
    if ((++_sp & 255u) == 0u) { if (xb_ld(&(bar)[XB_TMO])) break; if (_sp > XB_SPIN_CAP) { atomicAdd(&(bar)[XB_TMO], 1u); break; } } } } while (0)

struct XcdBarrier {
    unsigned* bar; unsigned x;
    volatile LAS unsigned* st;
};

__device__ __forceinline__ XcdBarrier xcd_barrier_post(unsigned* bar, volatile LAS unsigned* st) {
    XcdBarrier b; b.bar = bar; b.x = xb_xcc_id(); b.st = st;
    if (threadIdx.x == 0) (void)xb_add(&bar[XB_XCNT(b.x)], 1u);
    return b;
}
__device__ __forceinline__ void xcd_barrier_complete(unsigned* bar, unsigned x, unsigned& nloc, unsigned& nx) {
    const unsigned G = gridDim.x * gridDim.y * gridDim.z;
    unsigned sum, cnt, mine, sp = 0u;
    for (;;) {
        sum = 0u; cnt = 0u; mine = 0u;
#pragma unroll
        for (unsigned j = 0; j < 16; ++j) { const unsigned c = xb_ld(&bar[XB_XCNT(j)]); sum += c; cnt += (c > 0u) ? 1u : 0u; mine = (j == x) ? c : mine; }
        if (sum == G) break;
        __builtin_amdgcn_s_sleep(1);
        if ((++sp & 255u) == 0u) { if (xb_ld(&bar[XB_TMO])) break; if (sp > XB_SPIN_CAP) { atomicAdd(&bar[XB_TMO], 1u); break; } }
    }
    nloc = mine > 0u ? mine : 1u; nx = cnt > 0u ? cnt : 1u;
}

__device__ __forceinline__ void xcd_barrier(const XcdBarrier& b) {
    asm volatile("s_waitcnt vmcnt(0)" ::: "memory");
    __syncthreads();
    if (threadIdx.x == 0) {
        unsigned* bar = b.bar;
        __builtin_amdgcn_s_waitcnt(0);
        unsigned nloc = b.st[0], nx = b.st[1];
        if (nloc == 0u) { xcd_barrier_complete(bar, b.x, nloc, nx); b.st[0] = nloc; b.st[1] = nx; }
        const unsigned old = xb_add(&bar[XB_XSUB(b.x)], 1u);
        const unsigned gen = old / nloc;
        if (old + 1u == (gen + 1u) * nloc) {
            __builtin_amdgcn_fence(__ATOMIC_RELEASE, "agent");
            asm volatile("s_waitcnt vmcnt(0)" ::: "memory");
            const unsigned og = xb_add(&bar[XB_TOP], 1u);
            const unsigned tg = og / nx;
            if (og + 1u == (tg + 1u) * nx) xb_add(&bar[XB_TOPGEN], 1u);
            else XB_SPIN(xb_ld(&bar[XB_TOPGEN]) == tg, bar);
            __builtin_amdgcn_fence(__ATOMIC_ACQUIRE, "agent");
            xb_add(&bar[XB_XGEN(b.x)], 1u);
            asm volatile("s_waitcnt vmcnt(0)" ::: "memory");
        } else {
            XB_SPIN(xb_ld(&bar[XB_XGEN(b.x)]) == gen, bar);
            __builtin_amdgcn_fence(__ATOMIC_ACQUIRE, "agent");
            asm volatile("s_waitcnt vmcnt(0)" ::: "memory");
        }
    }
    __syncthreads();
}

struct Args { const float* in[17]; float* out; unsigned char* ws; int ph_lo, ph_hi, rep_mask, sync_rep; };
constexpr int NPHASE = 6;

template <class Epi> DI void run_gemm(LAS unsigned char* lds, const bf16* A, const bf16* Bt, int N, int K, const Epi& E) {
    pg8::Gemm g{A, Bt, M, N, K}; pg8::StaticOrder S; S.init(M, N, (int)gridDim.x, (int)blockIdx.x);
    pg8::gemm_phase<Epi, pg8::StaticOrder, true, true>(lds, g, S, E);
}


struct GroupOrder {
    int pm, pn0, step, cnt;
    __device__ __forceinline__ bool next(int i, pg8::Unit& u) const { if (i >= cnt) return false; u.pm = pm; u.pn = pn0 + i * step; return true; }
    __device__ __forceinline__ void a_ready(const pg8::Unit&) const {}
    __device__ __forceinline__ void done(const pg8::Unit&) const {}
};
DI void group_sync(unsigned* cnt, unsigned target, bool same_xcd) {
    asm volatile("s_waitcnt vmcnt(0)" ::: "memory");
    __syncthreads();
    if (threadIdx.x == 0) {
        if (!same_xcd) {
            __builtin_amdgcn_fence(__ATOMIC_RELEASE, "agent");
            asm volatile("s_waitcnt vmcnt(0)" ::: "memory");
        }
        (void)xb_add(cnt, 1u);
        unsigned sp = 0u;
        while (xb_ld(cnt) < target) { __builtin_amdgcn_s_sleep(1); if (++sp > (1u << 22)) break; }
        __builtin_amdgcn_fence(__ATOMIC_ACQUIRE, "agent");
        asm volatile("s_waitcnt vmcnt(0)" ::: "memory");
    }
    __syncthreads();
}
template <class Epi> DI void run_gemm_g(LAS unsigned char* lds, const bf16* A, const bf16* Bt, int N, int K, const GroupOrder& S, const Epi& E) {
    pg8::Gemm g{A, Bt, M, N, K};
    pg8::gemm_phase<Epi, GroupOrder, true, true>(lds, g, S, E);
}

__global__ void __launch_bounds__(NTHR, 2) mega_fwd(Args args) {
    extern __shared__ __attribute__((aligned(16))) unsigned char lds_raw[];
    LAS unsigned char* lds = (LAS unsigned char*)lds_raw;
    cg::grid_group grid = cg::this_grid();
    const int tid = threadIdx.x, lane = tid & 63, wave = __builtin_amdgcn_readfirstlane(tid >> 6);
    Ptrs P;
    P.x = args.in[0]; P.pos = (const int*)args.in[1]; P.norm_mix = args.in[2]; P.norm_mlp = args.in[3]; P.w_up = args.in[4]; P.w_down = args.in[5];
    P.w_in = args.in[6]; P.w_out = args.in[7]; P.gn_gain = args.in[8]; P.dq_gain = args.in[9]; P.dk_gain = args.in[10]; P.w_qkv = args.in[11];
    P.b_qkv = args.in[12]; P.swa_w_out = args.in[13]; P.sq_gain = args.in[14]; P.sk_gain = args.in[15]; P.sinks = args.in[16];
    P.out = args.out; P.ws = args.ws;
    unsigned char* ws = args.ws;
    float* ss = (float*)(ws + WS_SS);
    const int lo = args.ph_lo, hi = args.ph_hi; const int dryv = args.rep_mask;
    if (lo < 0) grid.sync();
    volatile LAS unsigned* MISC = (volatile LAS unsigned*)(lds + 131072 + 64);
    if (tid < 32) MISC[tid] = 0u;
    __syncthreads();
    XcdBarrier bar; bar.bar = (unsigned*)(ws + WS_BAR); bar.x = 0; bar.st = MISC + 8;
    if (hi - lo > 1) bar = xcd_barrier_post((unsigned*)(ws + WS_BAR), MISC + 8);
    if (tid == 0) __hip_atomic_store((unsigned*)(ws + WS_XID) + blockIdx.x, xb_xcc_id() + 1u, __ATOMIC_RELAXED, __HIP_MEMORY_SCOPE_AGENT);
#define IN(k) (lo <= (k) && (k) < hi)
#define SEAM(k) do { if (IN(k) && IN((k) + 1)) { for (int sr_ = 0; sr_ < srep; ++sr_) xcd_barrier(bar); } } while (0)
#if SYNC_REP != 1
    const int srep = args.sync_rep;
#else
    constexpr int srep = 1;
#endif

    if (IN(0)) { p0_prologue(P, lds, wave, lane); __syncthreads(); }
    SEAM(0);
    if (IN(1)) {
        EpiProj<0> E{(bf16*)(ws + WS_PROJ), ss, nullptr, (const float*)(ws + WS_ROPER), (const float*)(ws + WS_ROPED), P.dq_gain, P.dk_gain, (bf16*)(ws + WS_DIL)};
        run_gemm(lds, (const bf16*)(ws + WS_XA), (const bf16*)(ws + WS_WIN), NIN, D, E);
    }
    SEAM(1);
    if (IN(2)) {
        dil_phase(P, lds, tid, wave, lane);
        for (int u = blockIdx.x; u < 512; u += gridDim.x) retA_unit(u, P, lds, tid, wave, lane);
    }
    SEAM(2);
    const int gxcd = blockIdx.x & 7, gq = blockIdx.x >> 3, gslot = gq >> 2, grp_id = gxcd + 8 * gslot, mi = gq & 3;
    unsigned* gcnt = (unsigned*)(ws + WS_GRP) + 64 * grp_id;
    bool same_xcd = false;
    if (lo <= 0 && hi >= 4) {
        const unsigned* xid = (const unsigned*)(ws + WS_XID) + gxcd + 32 * gslot;
        const unsigned i0 = __hip_atomic_load(xid, __ATOMIC_RELAXED, __HIP_MEMORY_SCOPE_AGENT), i1 = __hip_atomic_load(xid + 8, __ATOMIC_RELAXED, __HIP_MEMORY_SCOPE_AGENT);
        const unsigned i2 = __hip_atomic_load(xid + 16, __ATOMIC_RELAXED, __HIP_MEMORY_SCOPE_AGENT), i3 = __hip_atomic_load(xid + 24, __ATOMIC_RELAXED, __HIP_MEMORY_SCOPE_AGENT);
        same_xcd = (i0 != 0u) && (i0 == i1) && (i0 == i2) && (i0 == i3);
    }
    if (IN(3)) {
        { float R[2][8];
          const int uA = (grp_id >> 4) * 128 + mi * 32 + 2 * (grp_id & 15);
          retB_unit(uA, P, lds, tid, wave, lane, R, false, true);
          retB_unit(uA + 1, P, lds, tid, wave, lane, R, true, false);
          dil_combine(P, 256 * grp_id, 256 * 64, mi * NTHR + tid, 4 * NTHR); }
        group_sync(gcnt, 4u, same_xcd);
        unsigned* rdone = (unsigned*)(ws + WS_BAR) + 3584;
        if (tid == 0) (void)xb_add(rdone, 1u);
        { EpiResid<true, false, false> E{nullptr, (const bf16*)(ws + WS_XA), nullptr, (bf16*)(ws + WS_XB), ss + M, dryv, 1, rdone, gridDim.x}; GroupOrder S{2 * grp_id, mi, 1, 1};
          run_gemm_g(lds, (const bf16*)P.out, (const bf16*)(ws + WS_WOUT), D, D, S, E); }
        group_sync(gcnt, 8u, same_xcd);
        { EpiRowScale<1, false> E{(bf16*)(ws + WS_HID), FF, ss + M, nullptr}; GroupOrder S{grp_id, 4 * mi, 1, 4};
          run_gemm_g(lds, (const bf16*)(ws + WS_XB), (const bf16*)(ws + WS_UP0), FF, D, S, E); }
        group_sync(gcnt, 12u, same_xcd);
        { EpiResid<true, false, false> E{nullptr, (const bf16*)(ws + WS_XB), nullptr, (bf16*)(ws + WS_XA), ss + 2 * M, dryv, 0, nullptr, 0u}; GroupOrder S{grp_id, mi, 1, 1};
          run_gemm_g(lds, (const bf16*)(ws + WS_HID), (const bf16*)(ws + WS_DN0), D, FF, S, E); }
    }
    SEAM(3);
    if (IN(4)) {
        EpiProj<1> E{(bf16*)(ws + WS_PROJ), ss + 2 * M, P.b_qkv, nullptr, (const float*)(ws + WS_ROPED), P.sq_gain, P.sk_gain, nullptr};
        run_gemm(lds, (const bf16*)(ws + WS_XA), (const bf16*)(ws + WS_QKV), NQKV, D, E);
        if (gridDim.x == 256 && blockIdx.x >= 128) { __syncthreads(); p0_late(P, lds, wave, lane, 128); }
        else if (gridDim.x != 256) { __syncthreads(); p0_late(P, lds, wave, lane, 0); }
    }
    SEAM(4);
    if (IN(5)) {
        unsigned char* hidg = (grp_id < 56) ? ws + (size_t)(133 + 2 * grp_id) * MiB : ws + (size_t)(1 + 2 * (grp_id - 56)) * MiB;
        bf16* hid0 = (bf16*)hidg - (size_t)grp_id * 256 * FF;
        swa_phase(P, lds, tid, wave, lane, (grp_id >> 4) * 256 + mi * 64 + 4 * (grp_id & 15), 1, 4);
        group_sync(gcnt, 16u, same_xcd);
        { EpiResid<true, false, false> E{nullptr, (const bf16*)(ws + WS_XA), nullptr, (bf16*)(ws + WS_XA), ss + 3 * M, dryv, 1, nullptr, 0u}; GroupOrder S{2 * grp_id, mi, 1, 1};
          run_gemm_g(lds, (const bf16*)P.out, (const bf16*)(ws + WS_SWO), D, D, S, E); }
        group_sync(gcnt, 20u, same_xcd);
        { EpiRowScale<1, false> E{hid0, FF, ss + 3 * M, nullptr}; GroupOrder S{grp_id, 4 * mi, 1, 4};
          run_gemm_g(lds, (const bf16*)(ws + WS_XA), (const bf16*)(ws + WS_UP1), FF, D, S, E); }
        group_sync(gcnt, 24u, same_xcd);
        { EpiResid<true, true, true> E{nullptr, (const bf16*)(ws + WS_XA), P.out, nullptr, nullptr, dryv, 0, nullptr, 0u}; GroupOrder S{grp_id, mi, 1, 1};
          run_gemm_g(lds, (const bf16*)hid0, (const bf16*)(ws + WS_DN1), D, FF, S, E); }
    }
#undef IN
#undef SEAM
}

#ifndef MK_PER_PHASE
#define MK_PER_PHASE 0
#endif
extern "C" void kernel_launch(void* const* d_in, const int* in_sizes, int n_in, void* d_out, int out_size, void* d_ws, size_t ws_size, hipStream_t stream) {
    static int grid = 0;
    if (grid == 0) {
        if (n_in != 17 || out_size != M * D || ws_size < WS_END) { fprintf(stderr, "kernel_launch: unexpected shapes (n_in %d out %d ws %zu)\n", n_in, out_size, ws_size); grid = -1; return; }
        int dev = 0, cus = 0, per_cu = 0;
        hipGetDevice(&dev); hipDeviceGetAttribute(&cus, hipDeviceAttributeMultiprocessorCount, dev);
        if (hipFuncSetAttribute((const void*)mega_fwd, hipFuncAttributeMaxDynamicSharedMemorySize, LDS_BYTES) != hipSuccess) { fprintf(stderr, "kernel_launch: hipFuncSetAttribute failed\n"); grid = -1; return; }
        if (hipOccupancyMaxActiveBlocksPerMultiprocessor(&per_cu, (const void*)mega_fwd, NTHR, LDS_BYTES) != hipSuccess || per_cu < 1) { fprintf(stderr, "kernel_launch: occupancy query says %d\n", per_cu); per_cu = 1; }
        (void)hipGetLastError();
        grid = cus * 1;
        if (grid != 256) { fprintf(stderr, "kernel_launch: built for 256 CUs (got %d)\n", cus); grid = 256; }
        fprintf(stderr, "kernel_launch: cus %d per_cu %d grid %d\n", cus, per_cu, grid);
    }
    if (grid < 0) return;
    if (hipMemsetAsync((char*)d_ws + WS_BAR, 0, WS_BAR_BYTES, stream) != hipSuccess) { fprintf(stderr, "kernel_launch: memset failed\n"); return; }
    Args a{};
    for (int i = 0; i < 17; ++i) a.in[i] = (const float*)d_in[i];
    a.out = (float*)d_out; a.ws = (unsigned char*)d_ws; a.rep_mask = 0; a.sync_rep = SYNC_REP;
#if MK_PER_PHASE
    for (int ph = 0; ph < NPHASE; ++ph) { a.ph_lo = ph; a.ph_hi = ph + 1; hipLaunchKernelGGL(mega_fwd, dim3(grid), dim3(NTHR), LDS_BYTES, stream, a); }
#else
    a.ph_lo = 0; a.ph_hi = NPHASE;
    void* kargs[] = {&a};
    hipError_t e = hipLaunchCooperativeKernel((const void*)mega_fwd, dim3(grid), dim3(NTHR), kargs, LDS_BYTES, stream);
    if (e != hipSuccess) fprintf(stderr, "kernel_launch: cooperative launch failed: %s (grid %d)\n", hipGetErrorString(e), grid);
#ifdef REP_EMPTY
    for (int i = 0; i < REP_EMPTY; ++i) { Args b2 = a; b2.ph_lo = NPHASE; b2.ph_hi = NPHASE; b2.rep_mask = 1; hipLaunchKernelGGL(mega_fwd, dim3(grid), dim3(NTHR), LDS_BYTES, stream, b2); }
#endif
#if REP_MASK != 0
    for (int ph = 0; ph < NPHASE; ++ph) if ((REP_MASK >> ph) & 1) { Args b2 = a; b2.ph_lo = ph; b2.ph_hi = ph + 1; b2.rep_mask = 1; hipLaunchKernelGGL(mega_fwd, dim3(grid), dim3(NTHR), LDS_BYTES, stream, b2); }
#endif
#endif
}
```

```cpp
#include <hip/hip_runtime.h>
#include <hip/hip_cooperative_groups.h>
#include <cstdio>
#include <cstdint>
namespace cg = cooperative_groups;
namespace pg8 {
#define PG8_LAS __attribute__((address_space(3)))
typedef unsigned short bf16_t;
typedef short bf16x8 __attribute__((ext_vector_type(8)));
typedef float f32x4 __attribute__((ext_vector_type(4)));
typedef unsigned u32x4 __attribute__((ext_vector_type(4)));
constexpr int BM = 256, BK = 64, HALF = 128, HTB = HALF * BK * 2  , STAGE_BYTES = 8 * HTB, NXCD = 8, WGM = 8;

__host__ __device__ __forceinline__ int lds_byte(int r, int c) { const int st = (r >> 4) * 2 + (c >> 5), rr = r & 15, cc = c & 31, ob = rr * 64 + cc * 2; return st * 1024 + (ob ^ (((ob >> 9) & 1) << 5)); }
__host__ __device__ __forceinline__ void stage_rc(int b, int& R, int& C) { const int st = b / 1024, sb = b % 1024, swz = sb ^ (((sb >> 9) & 1) << 5); R = (st >> 1) * 16 + swz / 64; C = (st & 1) * 32 + (swz % 64) / 2; }
__host__ __device__ __forceinline__ int perm32(int rho) { const int n = rho >> 4, i = rho & 15; return 8 * (i >> 2) + 4 * n + (i & 3); }

struct Unit { int pm, pn; };
struct Gemm { const bf16_t* A; const bf16_t* Bt; int M, N, K; };

struct StaticOrder {
    int nM, nN, nwg, G, c;
    __host__ __device__ void init(int M, int N, int G_, int c_) { nM = M / BM; nN = N / BM; nwg = nM * nN; G = G_; c = c_; }
    __host__ __device__ bool next(int i, Unit& u) const {
        const long L = (long)i * G + c; if (L >= nwg) return false;
        int wgid = (int)L; { const int q = nwg / NXCD, r = nwg % NXCD, xcd = wgid % NXCD, off = wgid / NXCD; wgid = (xcd < r ? xcd * (q + 1) : r * (q + 1) + (xcd - r) * q) + off; }
        const int nig = WGM * nN, gid = wgid / nig, fm = gid * WGM, gsz = (nM - fm) < WGM ? (nM - fm) : WGM;
        u.pm = fm + ((wgid % nig) % gsz); u.pn = (wgid % nig) / gsz; return true;
    }
    __device__ __forceinline__ void a_ready(const Unit&) const {}
    __device__ __forceinline__ void done(const Unit&) const {}
};

__device__ __forceinline__ unsigned cvt_pk_bf16(float lo, float hi) { typedef __bf16 b2 __attribute__((ext_vector_type(2))); typedef float f2 __attribute__((ext_vector_type(2))); f2 v = {lo, hi}; return __builtin_bit_cast(unsigned, __builtin_convertvector(v, b2)); }
template <class Epi, class Sched, bool ALIGN_EPI = false, bool SP2 = false>
__device__ __forceinline__ void gemm_phase(PG8_LAS unsigned char* lds, const Gemm g, const Sched& S, const Epi& E) {
    const int tid = threadIdx.x, wid = __builtin_amdgcn_readfirstlane(tid >> 6), lane = tid & 63, wr = wid >> 2, wc = wid & 3, fr = lane & 15, fq = lane >> 4;
    const int K = g.K, nt = K / BK;
    unsigned voffA[2], voffB[2];
#pragma unroll
    for (int i = 0; i < 2; ++i) { int R, C; stage_rc(tid * 16 + i * 8192, R, C); const int Rb = Epi::PERM ? ((R & ~31) + perm32(R & 31)) : R;
        voffA[i] = (unsigned)(R * K + C) * 2u; voffB[i] = (unsigned)(Rb * K + C) * 2u; }
    const size_t kstep = (size_t)(BK * 2);
    const size_t hstep = (size_t)HALF * K * 2;
    const size_t tstep = 2 * hstep;
    const unsigned ldsw = (unsigned)wid * 1024u;
    const int aoff = lds_byte(wr * 64 + fr, fq * 8), boff = lds_byte(wc * 32 + fr, fq * 8);
#define PG8_SA(b, h) (((b) * 2 + (h)) * HTB)
#define PG8_SB(b, h) ((4 + (b) * 2 + (h)) * HTB)
#define PG8_STAGE(bufoff, gbase, voff) do { _Pragma("unroll") for (int _i = 0; _i < 2; ++_i) \
        __builtin_amdgcn_global_load_lds((const unsigned*)((const char*)(gbase) + (voff)[_i]), (PG8_LAS unsigned*)(lds + (bufoff) + ldsw + _i * 8192), 16, 0, 0); } while (0)
#define PG8_LDA(dst, b, h) do { _Pragma("unroll") for (int m = 0; m < 4; ++m) _Pragma("unroll") for (int k = 0; k < 2; ++k) dst[m][k] = *(const PG8_LAS bf16x8*)(lds + PG8_SA(b, h) + aoff + m * 2048 + k * 1024); } while (0)
#define PG8_LDB(dst, b, h) do { _Pragma("unroll") for (int n = 0; n < 2; ++n) _Pragma("unroll") for (int k = 0; k < 2; ++k) dst[n][k] = *(const PG8_LAS bf16x8*)(lds + PG8_SB(b, h) + boff + n * 2048 + k * 1024); } while (0)
#define PG8_MMA(ai, bj, At, Bt) do { __builtin_amdgcn_s_setprio(1); _Pragma("unroll") for (int m = 0; m < 4; ++m) _Pragma("unroll") for (int n = 0; n < 2; ++n) _Pragma("unroll") for (int k = 0; k < 2; ++k) \
        acc[ai][bj][m][n] = __builtin_amdgcn_mfma_f32_16x16x32_bf16(Bt[n][k], At[m][k], acc[ai][bj][m][n], 0, 0, 0); __builtin_amdgcn_s_setprio(0); } while (0)
#define PG8_WAIT_V(n) asm volatile("s_waitcnt vmcnt(" #n ")" ::: "memory")
#define PG8_WAIT_L(n) asm volatile("s_waitcnt lgkmcnt(" #n ")" ::: "memory")
#define PG8_BAR __builtin_amdgcn_s_barrier()
#define PG8_SCHED __builtin_amdgcn_sched_barrier(0)
    Unit cur, nxt; int ui = 0;
    if (!S.next(0, cur)) return;
    f32x4 acc[2][2][4][2];
#pragma unroll
    for (int a = 0; a < 2; ++a)
#pragma unroll
        for (int b = 0; b < 2; ++b)
#pragma unroll
            for (int m = 0; m < 4; ++m)
#pragma unroll
                for (int n = 0; n < 2; ++n) acc[a][b][m][n] = (f32x4){0.f, 0.f, 0.f, 0.f};
    bf16x8 At[4][2], B0[2][2], B1[2][2];
    const char* cA = (const char*)g.A + (size_t)cur.pm * tstep; const char* cB = (const char*)g.Bt + (size_t)cur.pn * tstep;
    S.a_ready(cur);
    if constexpr (SP2) {
        PG8_STAGE(PG8_SB(0, 0), cB, voffB); PG8_STAGE(PG8_SB(0, 1), cB + hstep, voffB); PG8_STAGE(PG8_SA(0, 0), cA, voffA); PG8_STAGE(PG8_SA(0, 1), cA + hstep, voffA);
        if (wr == 1) PG8_BAR;
        PG8_WAIT_V(2); PG8_BAR;
        PG8_STAGE(PG8_SB(1, 0), cB + kstep, voffB); PG8_STAGE(PG8_SA(1, 0), cA + kstep, voffA); PG8_STAGE(PG8_SB(1, 1), cB + hstep + kstep, voffB);
        PG8_WAIT_V(6); PG8_BAR;
    } else {
        PG8_STAGE(PG8_SB(0, 0), cB, voffB); PG8_STAGE(PG8_SA(0, 0), cA, voffA); PG8_STAGE(PG8_SB(0, 1), cB + hstep, voffB); PG8_STAGE(PG8_SA(0, 1), cA + hstep, voffA);
        if (wr == 1) PG8_BAR;
        PG8_WAIT_V(4); PG8_BAR;
        PG8_STAGE(PG8_SB(1, 0), cB + kstep, voffB); PG8_STAGE(PG8_SA(1, 0), cA + kstep, voffA); PG8_STAGE(PG8_SB(1, 1), cB + hstep + kstep, voffB);
        PG8_WAIT_V(6); PG8_BAR;
    }
    for (;;) {
        const bool has_next = S.next(ui + 1, nxt);
        const char* nA = has_next ? (const char*)g.A + (size_t)nxt.pm * tstep : cA; const char* nB = has_next ? (const char*)g.Bt + (size_t)nxt.pn * tstep : cB;
        for (int t = 0; t < nt; t += 2) {
            const bool last = (t == nt - 2);
            const char* a1 = cA + (size_t)(t + 1) * kstep;
            const char* a2 = last ? nA : cA + (size_t)(t + 2) * kstep; const char* b2 = last ? nB : cB + (size_t)(t + 2) * kstep;
            const char* a3 = a2 + kstep; const char* b3 = b2 + kstep;
            if (last && has_next) S.a_ready(nxt);
            if constexpr (SP2) {
            PG8_LDB(B0, 0, 0); PG8_LDB(B1, 0, 1); PG8_SCHED; PG8_LDA(At, 0, 0); PG8_STAGE(PG8_SA(1, 1), a1 + hstep, voffA);
            PG8_WAIT_V(8); PG8_WAIT_L(0); PG8_BAR; PG8_MMA(0, 0, At, B0); PG8_MMA(0, 1, At, B1); PG8_BAR; PG8_SCHED;
            PG8_LDA(At, 0, 1); PG8_STAGE(PG8_SB(0, 0), b2, voffB); PG8_STAGE(PG8_SB(0, 1), b2 + hstep, voffB); PG8_STAGE(PG8_SA(0, 0), a2, voffA);
            PG8_WAIT_V(8); PG8_WAIT_L(0); PG8_BAR; PG8_MMA(1, 0, At, B0); PG8_MMA(1, 1, At, B1); PG8_BAR; PG8_SCHED;
            PG8_LDB(B0, 1, 0); PG8_LDB(B1, 1, 1); PG8_SCHED; PG8_LDA(At, 1, 0); PG8_STAGE(PG8_SA(0, 1), a2 + hstep, voffA);
            PG8_WAIT_V(8); PG8_WAIT_L(0); PG8_BAR; PG8_MMA(0, 0, At, B0); PG8_MMA(0, 1, At, B1); PG8_BAR; PG8_SCHED;
            PG8_LDA(At, 1, 1); PG8_STAGE(PG8_SB(1, 0), b3, voffB); PG8_STAGE(PG8_SB(1, 1), b3 + hstep, voffB); PG8_STAGE(PG8_SA(1, 0), a3, voffA);
            PG8_WAIT_V(8); PG8_WAIT_L(0); PG8_BAR; PG8_MMA(1, 0, At, B0); PG8_MMA(1, 1, At, B1); PG8_BAR; PG8_SCHED;
            } else {
            PG8_LDB(B0, 0, 0); PG8_SCHED; PG8_LDA(At, 0, 0); PG8_STAGE(PG8_SA(1, 1), a1 + hstep, voffA);
            PG8_WAIT_L(8); PG8_BAR; PG8_WAIT_L(0); PG8_MMA(0, 0, At, B0); PG8_BAR; PG8_SCHED;
            PG8_LDB(B1, 0, 1); PG8_STAGE(PG8_SB(0, 0), b2, voffB);
            PG8_BAR; PG8_WAIT_L(0); PG8_MMA(0, 1, At, B1); PG8_BAR;
            PG8_LDA(At, 0, 1); PG8_STAGE(PG8_SA(0, 0), a2, voffA);
            PG8_BAR; PG8_WAIT_L(0); PG8_MMA(1, 0, At, B0); PG8_BAR; PG8_SCHED;
            PG8_STAGE(PG8_SB(0, 1), b2 + hstep, voffB);
            PG8_WAIT_V(6); PG8_BAR; PG8_MMA(1, 1, At, B1); PG8_BAR;
            PG8_LDB(B0, 1, 0); PG8_SCHED; PG8_LDA(At, 1, 0); PG8_STAGE(PG8_SA(0, 1), a2 + hstep, voffA);
            PG8_WAIT_L(8); PG8_BAR; PG8_WAIT_L(0); PG8_MMA(0, 0, At, B0); PG8_BAR; PG8_SCHED;
            PG8_LDB(B1, 1, 1); PG8_STAGE(PG8_SB(1, 0), b3, voffB);
            PG8_BAR; PG8_WAIT_L(0); PG8_MMA(0, 1, At, B1); PG8_BAR;
            PG8_LDA(At, 1, 1); PG8_STAGE(PG8_SA(1, 0), a3, voffA);
            PG8_BAR; PG8_WAIT_L(0); PG8_MMA(1, 0, At, B0); PG8_BAR; PG8_SCHED;
            PG8_STAGE(PG8_SB(1, 1), b3 + hstep, voffB);
            PG8_WAIT_V(6); PG8_BAR; PG8_MMA(1, 1, At, B1); PG8_BAR;
            }
        }
        if constexpr (ALIGN_EPI) { if (wr == 0) PG8_BAR; }
        if constexpr (!Epi::AFTER_DRAIN) { E(acc, cur, wr, wc, fr, fq); S.done(cur); }
        if (!has_next) break;
#pragma unroll
        for (int a = 0; a < 2; ++a)
#pragma unroll
            for (int b = 0; b < 2; ++b)
#pragma unroll
                for (int m = 0; m < 4; ++m)
#pragma unroll
                    for (int n = 0; n < 2; ++n) acc[a][b][m][n] = (f32x4){0.f, 0.f, 0.f, 0.f};
        cur = nxt; cA = nA; cB = nB; ++ui;
        if constexpr (ALIGN_EPI) { if (wr == 1) PG8_BAR; }
    }
    PG8_WAIT_V(0);
    if constexpr (!ALIGN_EPI) { if (wr == 0) PG8_BAR; }
    PG8_BAR;
    if constexpr (Epi::AFTER_DRAIN) { E.fused(acc, cur, wr, wc, fr, fq, lds, wid, lane); S.done(cur); }
#undef PG8_SA
#undef PG8_SB
#undef PG8_STAGE
#undef PG8_LDA
#undef PG8_LDB
#undef PG8_MMA
#undef PG8_WAIT_V
#undef PG8_WAIT_L
#undef PG8_BAR
#undef PG8_SCHED
}
}

#ifndef REP_MASK
#define REP_MASK 0
#endif
#ifndef SYNC_REP
#define SYNC_REP 1
#endif
#define GAS __attribute__((address_space(1)))
#define LAS __attribute__((address_space(3)))
#define DI __device__ __forceinline__
typedef unsigned short bf16;
typedef unsigned v4u __attribute__((ext_vector_type(4)));
typedef unsigned v2u __attribute__((ext_vector_type(2)));
typedef float f32x4 __attribute__((ext_vector_type(4)));
typedef float f32x16 __attribute__((ext_vector_type(16)));
typedef short bf16x8 __attribute__((ext_vector_type(8)));
typedef short s16x4 __attribute__((ext_vector_type(4)));
#define MFMA32(a, b, c) __builtin_amdgcn_mfma_f32_32x32x16_bf16((a), (b), (c), 0, 0, 0)

constexpr int NWAVES = 8, NTHR = 512;
constexpr int BATCH = 4, SEQ = 4096, D = 1024, M = BATCH * SEQ, FF = 4096;
constexpr int NIN = 3072, NQKV = 1536;
constexpr float EPS = 1e-6f;
constexpr float LOG2E = 1.4426950408889634f, LN2 = 0.6931471805599453f;
constexpr float QSCALE = 0.125f * LOG2E;

constexpr size_t MiB = 1u << 20;
constexpr size_t WS_BAR = 512 * 1024, WS_GRP = WS_BAR + 16384, WS_BAR_BYTES = 32768, WS_XID = WS_BAR + 32768;
constexpr size_t WS_SS = 0;
constexpr size_t WS_WIN = 1 * MiB, WS_WOUT = 7 * MiB, WS_UP0 = 9 * MiB, WS_UP1 = 17 * MiB, WS_DN0 = 25 * MiB, WS_DN1 = 33 * MiB, WS_QKV = 41 * MiB, WS_SWO = 44 * MiB;
constexpr size_t WS_ROPER = 46 * MiB, WS_ROPED = 50 * MiB, WS_LSE = 51 * MiB;
constexpr size_t WS_XA = 53 * MiB;
constexpr size_t WS_PROJ = 85 * MiB;
constexpr size_t WS_XB = 85 * MiB;
constexpr size_t WS_HID = 117 * MiB;
constexpr size_t WS_AO = WS_XA;
constexpr size_t WS_OP = 181 * MiB;
constexpr size_t WS_SB = 229 * MiB;
constexpr size_t WS_END = 245 * MiB;
constexpr int LDS_BYTES = 147456;

DI unsigned pk2(float lo, float hi) { return pg8::cvt_pk_bf16(lo, hi); }
DI float bf_lo(unsigned u) { return __uint_as_float(u << 16); }
DI float bf_hi(unsigned u) { return __uint_as_float(u & 0xffff0000u); }
DI int crow(int i, int h) { return (i & 3) + 8 * (i >> 2) + 4 * h; }
DI bf16x8 pack8(const f32x16& x, int s) {
    v4u p; p.x = pk2(x[8 * s], x[8 * s + 1]); p.y = pk2(x[8 * s + 2], x[8 * s + 3]); p.z = pk2(x[8 * s + 4], x[8 * s + 5]); p.w = pk2(x[8 * s + 6], x[8 * s + 7]);
    return __builtin_bit_cast(bf16x8, p);
}
DI bf16x8 cat4(s16x4 lo, s16x4 hi) { return __builtin_shufflevector(lo, hi, 0, 1, 2, 3, 4, 5, 6, 7); }
DI unsigned lds_addr(const LAS void* p) { return (unsigned)(uintptr_t)p; }
#define TR4(r0, r1, r2, r3, ad0, ad1) asm volatile("ds_read_b64_tr_b16 %0, %4\n\tds_read_b64_tr_b16 %1, %4 offset:512\n\tds_read_b64_tr_b16 %2, %5\n\tds_read_b64_tr_b16 %3, %5 offset:512\n\ts_waitcnt lgkmcnt(0)" \
    : "=&v"(r0), "=&v"(r1), "=&v"(r2), "=&v"(r3) : "v"(ad0), "v"(ad1) : "memory")
#define TR4N(r0, r1, r2, r3, ad0, ad1) asm volatile("ds_read_b64_tr_b16 %0, %4\n\tds_read_b64_tr_b16 %1, %4 offset:256\n\tds_read_b64_tr_b16 %2, %5\n\tds_read_b64_tr_b16 %3, %5 offset:256\n\ts_waitcnt lgkmcnt(0)" \
    : "=&v"(r0), "=&v"(r1), "=&v"(r2), "=&v"(r3) : "v"(ad0), "v"(ad1) : "memory")

template <int ACT, bool BIAS> struct EpiRowScale {
    static constexpr bool PERM = true, AFTER_DRAIN = false;
    bf16* O; int ldc; const float* ss; const float* bias;
    __device__ __forceinline__ void operator()(const pg8::f32x4 (&acc)[2][2][4][2], const pg8::Unit& u, int wr, int wc, int fr, int fq) const {
        const int row0 = u.pm * 256 + wr * 64 + fr, col0 = u.pn * 256 + wc * 32 + 8 * fq;
        f32x4 bv[2][2];
#pragma unroll
        for (int bj = 0; bj < 2; ++bj)
#pragma unroll
            for (int n = 0; n < 2; ++n) bv[bj][n] = BIAS ? *(const f32x4*)(bias + col0 + bj * 128 + 4 * n) : (f32x4){0.f, 0.f, 0.f, 0.f};
        float rs[2][4];
#pragma unroll
        for (int ai = 0; ai < 2; ++ai)
#pragma unroll
            for (int m = 0; m < 4; ++m) rs[ai][m] = ss[row0 + ai * 128 + m * 16];
#pragma unroll
        for (int ai = 0; ai < 2; ++ai)
#pragma unroll
            for (int m = 0; m < 4; ++m) {
                const int row = row0 + ai * 128 + m * 16;
                const float s = 1.0f / sqrtf(rs[ai][m] * (1.0f / 1024.0f) + EPS);
                bf16* rowp = O + (size_t)row * ldc + col0;
#pragma unroll
                for (int bj = 0; bj < 2; ++bj) {
                    f32x4 v0 = acc[ai][bj][m][0] * s + bv[bj][0], v1 = acc[ai][bj][m][1] * s + bv[bj][1];
                    if (ACT == 1) {
#pragma unroll
                        for (int e = 0; e < 4; ++e) { const float a = fmaxf(v0[e], 0.f), b = fmaxf(v1[e], 0.f); v0[e] = a * a; v1[e] = b * b; }
                    }
                    v4u w; w.x = pk2(v0[0], v0[1]); w.y = pk2(v0[2], v0[3]); w.z = pk2(v1[0], v1[1]); w.w = pk2(v1[2], v1[3]);
                    *(v4u*)(rowp + bj * 128) = w;
                }
            }
    }
};

template <int LAYER> struct EpiProj {
    static constexpr bool PERM = true, AFTER_DRAIN = false;
    bf16* O; const float* ss; const float* bias; const float* ropeR; const float* ropeD; const float* qg; const float* kg;
    __device__ __forceinline__ void operator()(const pg8::f32x4 (&acc)[2][2][4][2], const pg8::Unit& u, int wr, int wc, int fr, int fq) const {
        constexpr int LDC = LAYER == 0 ? NIN : NQKV;
        const int slot = 4 * u.pn + wc;
        int type = 0; float sc = 1.0f; const float* gain = qg;
        if (LAYER == 0) { if (slot < 8) { type = 1; sc = slot >= 4 ? 0.125f : 1.0f; } else if (slot >= 24 && slot < 40) { type = 2; if (slot < 32) sc = QSCALE; else gain = kg; } }
        else { if (slot < 20) { type = 2; if (slot < 16) sc = QSCALE; else gain = kg; } }
        const int row0 = u.pm * 256 + wr * 64 + fr, d0 = 8 * fq;
        f32x4 bv[2][2], gv[2][2];
#pragma unroll
        for (int bj = 0; bj < 2; ++bj)
#pragma unroll
            for (int n = 0; n < 2; ++n) {
                bv[bj][n] = (LAYER == 1) ? *(const f32x4*)(bias + 64 * slot + 32 * bj + d0 + 4 * n) : (f32x4){0.f, 0.f, 0.f, 0.f};
                gv[bj][n] = (type == 2) ? *(const f32x4*)(gain + 32 * bj + d0 + 4 * n) : (f32x4){1.f, 1.f, 1.f, 1.f};
            }
#pragma unroll
        for (int aim = 0; aim < 4; ++aim) {
            float rs[2]; f32x4 cc[2][2], sn[2][2];
#pragma unroll
            for (int mm = 0; mm < 2; ++mm) {
                const int row = row0 + (aim >> 1) * 128 + (2 * (aim & 1) + mm) * 16;
                rs[mm] = ss[row];
#pragma unroll
                for (int n = 0; n < 2; ++n) {
                    if (type == 1) { cc[mm][n] = *(const f32x4*)(ropeR + (size_t)row * 64 + d0 + 4 * n); sn[mm][n] = *(const f32x4*)(ropeR + (size_t)row * 64 + 32 + d0 + 4 * n); }
                    else if (type == 2) { cc[mm][n] = *(const f32x4*)(ropeD + (size_t)row * 16 + 4 * n); sn[mm][n] = *(const f32x4*)(ropeD + (size_t)row * 16 + 8 + 4 * n); }
                    else { cc[mm][n] = (f32x4){1.f, 1.f, 1.f, 1.f}; sn[mm][n] = (f32x4){0.f, 0.f, 0.f, 0.f}; }
                }
            }
#pragma unroll
            for (int mm = 0; mm < 2; ++mm) {
                const int ai = aim >> 1, m = 2 * (aim & 1) + mm;
                const int row = row0 + ai * 128 + m * 16;
                const float s = 1.0f / sqrtf(rs[mm] * (1.0f / 1024.0f) + EPS);
                f32x4 v[2][2];
#pragma unroll
                for (int bj = 0; bj < 2; ++bj)
#pragma unroll
                    for (int n = 0; n < 2; ++n) v[bj][n] = acc[ai][bj][m][n] * s + bv[bj][n];
                if (type == 1) {
#pragma unroll
                    for (int n = 0; n < 2; ++n) {
                        const f32x4 c4 = cc[mm][n], s4 = sn[mm][n];
                        const f32x4 x1 = v[0][n], x2 = v[1][n];
                        v[0][n] = (x1 * c4 - x2 * s4) * sc; v[1][n] = (x2 * c4 + x1 * s4) * sc;
                    }
                } else if (type == 2) {
                    float q = 0.f;
#pragma unroll
                    for (int bj = 0; bj < 2; ++bj)
#pragma unroll
                        for (int n = 0; n < 2; ++n) q += (v[bj][n][0] * v[bj][n][0] + v[bj][n][1] * v[bj][n][1]) + (v[bj][n][2] * v[bj][n][2] + v[bj][n][3] * v[bj][n][3]);
                    q += __shfl_xor(q, 16); q += __shfl_xor(q, 32);
                    const float r = 1.0f / sqrtf(q * (1.0f / 64.0f) + EPS);
#pragma unroll
                    for (int bj = 0; bj < 2; ++bj)
#pragma unroll
                        for (int n = 0; n < 2; ++n) v[bj][n] = v[bj][n] * r * gv[bj][n];
#pragma unroll
                    for (int n = 0; n < 2; ++n) {
                        const f32x4 c4 = cc[mm][n], s4 = sn[mm][n];
#pragma unroll
                        for (int e = 0; e < 4; ++e) {
                            const float own = v[0][n][e], other = __shfl_xor(own, 16);
                            const float rot = (fq == 0) ? (own * c4[e] - other * s4[e]) : (own * c4[e] + other * s4[e]);
                            v[0][n][e] = (fq < 2) ? rot : own;
                        }
                    }
#pragma unroll
                    for (int bj = 0; bj < 2; ++bj)
#pragma unroll
                        for (int n = 0; n < 2; ++n) v[bj][n] = v[bj][n] * sc;
                }
                bf16* rowp = O + (size_t)row * LDC + 64 * slot + d0;
#pragma unroll
                for (int bj = 0; bj < 2; ++bj) {
                    v4u w; w.x = pk2(v[bj][0][0], v[bj][0][1]); w.y = pk2(v[bj][0][2], v[bj][0][3]); w.z = pk2(v[bj][1][0], v[bj][1][1]); w.w = pk2(v[bj][1][2], v[bj][1][3]);
                    *(v4u*)(rowp + 32 * bj) = w;
                }
            }
        }
    }
};
template <bool BASEB, bool WF32, bool LAST> struct EpiResid {
    static constexpr bool PERM = true, AFTER_DRAIN = false;
    const float* base; const bf16* baseb; float* out; bf16* xb; float* ss; int dry; int pmsh;
    const unsigned* wcnt; unsigned wtarget;
    __device__ __forceinline__ void operator()(const pg8::f32x4 (&acc)[2][2][4][2], const pg8::Unit& u, int wr, int wc, int fr, int fq) const {
        const int row0 = (u.pm >> pmsh) * 256 + wr * 64 + fr, col0 = u.pn * 256 + wc * 32 + 8 * fq;
        if (dry) return;
        if (wcnt) { unsigned sp = 0u; while (__hip_atomic_load(wcnt, __ATOMIC_RELAXED, __HIP_MEMORY_SCOPE_AGENT) < wtarget) { __builtin_amdgcn_s_sleep(1); if (++sp > (1u << 22)) break; } }
#pragma unroll
        for (int ai = 0; ai < 2; ++ai) {
            f32x4 bs[4][2][2];
#pragma unroll
            for (int m = 0; m < 4; ++m) { const size_t off = (size_t)(row0 + ai * 128 + m * 16) * D + col0;
#pragma unroll
                for (int bj = 0; bj < 2; ++bj) {
                    if (BASEB) { const v4u r = *(const v4u*)(baseb + off + bj * 128);
                        bs[m][bj][0] = (f32x4){bf_lo(r.x), bf_hi(r.x), bf_lo(r.y), bf_hi(r.y)}; bs[m][bj][1] = (f32x4){bf_lo(r.z), bf_hi(r.z), bf_lo(r.w), bf_hi(r.w)}; }
                    else { bs[m][bj][0] = *(const f32x4*)(base + off + bj * 128); bs[m][bj][1] = *(const f32x4*)(base + off + bj * 128 + 4); } } }
#pragma unroll
            for (int m = 0; m < 4; ++m) {
                const int row = row0 + ai * 128 + m * 16;
                const size_t off = (size_t)row * D + col0;
                float part = 0.f;
#pragma unroll
                for (int bj = 0; bj < 2; ++bj) {
                    const f32x4 v0 = bs[m][bj][0] + acc[ai][bj][m][0], v1 = bs[m][bj][1] + acc[ai][bj][m][1];
                    if (WF32) { *(f32x4*)(out + off + bj * 128) = v0; *(f32x4*)(out + off + bj * 128 + 4) = v1; }
                    if (!LAST) {
                        v4u w; w.x = pk2(v0[0], v0[1]); w.y = pk2(v0[2], v0[3]); w.z = pk2(v1[0], v1[1]); w.w = pk2(v1[2], v1[3]);
                        *(v4u*)(xb + off + bj * 128) = w;
                        part += (v0[0] * v0[0] + v0[1] * v0[1]) + (v0[2] * v0[2] + v0[3] * v0[3]) + (v1[0] * v1[0] + v1[1] * v1[1]) + (v1[2] * v1[2] + v1[3] * v1[3]);
                    }
                }
                if (!LAST) {
                    part += __shfl_xor(part, 16); part += __shfl_xor(part, 32);
                    if (fq == 0) atomicAdd(ss + row, part);
                }
            }
        }
    }
};

DI float wave_sum(float v) {
#pragma unroll
    for (int o = 1; o < 64; o <<= 1) v += __shfl_xor(v, o);
    return v;
}
DI void p0_transpose_item(const float* W, int K, int N, bf16* WT, const float* gain, LAS float* scr, int item, int lane, bool perm = false) {
    const int nblk = N / 32, kb = item / nblk, nb = item % nblk, k0 = 64 * kb, n0 = 32 * nb;
    float t[32], gg[32];
#pragma unroll
    for (int i = 0; i < 32; ++i) { const int kk = 2 * i + (lane >> 5); t[i] = W[(size_t)(k0 + kk) * N + n0 + (lane & 31)]; gg[i] = gain ? gain[k0 + kk] : 1.0f; }
#pragma unroll
    for (int i = 0; i < 32; ++i) { const int kk = 2 * i + (lane >> 5); scr[kk * 33 + (lane & 31)] = t[i] * gg[i]; }
    asm volatile("s_waitcnt lgkmcnt(0)" ::: "memory");
    const int c = lane & 7;
#pragma unroll
    for (int j = 0; j < 4; ++j) { const int n = (lane >> 3) + 8 * j; const LAS float* s = scr + (8 * c) * 33 + n;
        v4u o; o.x = pk2(s[0 * 33], s[1 * 33]); o.y = pk2(s[2 * 33], s[3 * 33]); o.z = pk2(s[4 * 33], s[5 * 33]); o.w = pk2(s[6 * 33], s[7 * 33]);
        const int real = n0 + n, rowi = perm ? ((real & ~255) + 128 * ((real >> 5) & 1) + 32 * ((real >> 6) & 3) + (real & 31)) : real;
        *(v4u*)(WT + (size_t)rowi * K + k0 + 8 * c) = o; }
    asm volatile("s_waitcnt lgkmcnt(0)" ::: "memory");
}

struct Ptrs {
    const float *x, *norm_mix, *norm_mlp, *w_up, *w_down, *w_in, *w_out, *gn_gain, *dq_gain, *dk_gain, *w_qkv, *b_qkv, *swa_w_out, *sq_gain, *sk_gain, *sinks;
    const int* pos;
    float* out; unsigned char* ws;
};

DI void p0_prologue(const Ptrs& P, LAS unsigned char* lds, int wave, int lane) {
    LAS float* scr = (LAS float*)(lds + wave * 16384);
    const int gw = blockIdx.x * NWAVES + wave, NGW = gridDim.x * NWAVES;
    unsigned char* ws = P.ws;
    constexpr int I_IN = 16 * 96, I_OUT = 16 * 32, I_UP = 16 * 128, I_DN = 64 * 32, I_QKV = 16 * 48;
    constexpr int NITEMS = I_IN + I_OUT + I_UP + I_DN + I_QKV;
    for (int it = gw; it < NITEMS; it += NGW) {
        int r = it;
        if (r < I_IN) { p0_transpose_item(P.w_in, D, NIN, (bf16*)(ws + WS_WIN), P.norm_mix, scr, r, lane, true); continue; } r -= I_IN;
        if (r < I_OUT) { p0_transpose_item(P.w_out, D, D, (bf16*)(ws + WS_WOUT), nullptr, scr, r, lane); continue; } r -= I_OUT;
        if (r < I_UP) { p0_transpose_item(P.w_up, D, FF, (bf16*)(ws + WS_UP0), P.norm_mlp, scr, r, lane); continue; } r -= I_UP;
        if (r < I_DN) { p0_transpose_item(P.w_down, FF, D, (bf16*)(ws + WS_DN0), nullptr, scr, r, lane); continue; } r -= I_DN;
        p0_transpose_item(P.w_qkv, D, NQKV, (bf16*)(ws + WS_QKV), P.norm_mix + D, scr, r, lane, true);
    }
    float* ss = (float*)(ws + WS_SS);
    bf16* xa = (bf16*)(ws + WS_XA);
    for (int m = gw; m < M; m += NGW) {
        const f32x4* xr = (const f32x4*)(P.x + (size_t)m * D) + lane;
        f32x4 v[4]; float s = 0.f;
#pragma unroll
        for (int j = 0; j < 4; ++j) { v[j] = xr[64 * j]; s += (v[j].x * v[j].x + v[j].y * v[j].y) + (v[j].z * v[j].z + v[j].w * v[j].w); }
        s = wave_sum(s);
        v2u* o8 = (v2u*)(xa + (size_t)m * D) + lane;
#pragma unroll
        for (int j = 0; j < 4; ++j) { v2u w; w.x = pk2(v[j].x, v[j].y); w.y = pk2(v[j].z, v[j].w); o8[64 * j] = w; }
        if (lane == 0) ss[m] = s;
    }
    const int gt = blockIdx.x * NTHR + threadIdx.x, NGT = gridDim.x * NTHR;
    for (int i = gt; i < 3 * M; i += NGT) ss[M + i] = 0.f;
    float* ropeR = (float*)(ws + WS_ROPER); float* ropeD = (float*)(ws + WS_ROPED);
    for (int i = gt; i < M * 40; i += NGT) {
        const int m = i / 40, a = i % 40;
        const float pos = (float)P.pos[m];
        float inv;
        { const double arg = (a < 32) ? -(double)a * (13.287712379549449 / 32.0) : -(double)(a - 32) * (18.931568569324174 / 8.0);
          const double nf = floor(arg); inv = __builtin_ldexpf(__builtin_amdgcn_exp2f((float)(arg - nf)), (int)nf); }
        const float ang = pos * inv;
        const double rev = (double)ang * 0.15915494309189535;
        const float fr = (float)(rev - rint(rev));
        const float c = __builtin_amdgcn_cosf(fr), s = __builtin_amdgcn_sinf(fr);
        if (a < 32) { ropeR[(size_t)m * 64 + a] = c; ropeR[(size_t)m * 64 + 32 + a] = s; }
        else { ropeD[(size_t)m * 16 + (a - 32)] = c; ropeD[(size_t)m * 16 + 8 + (a - 32)] = s; }
    }
}


DI void p0_late(const Ptrs& P, LAS unsigned char* lds, int wave, int lane, int first) {
    LAS float* scr = (LAS float*)(lds + wave * 16384);
    const int nw = ((int)gridDim.x - first) * NWAVES, gw = ((int)blockIdx.x - first) * NWAVES + wave;
    constexpr int I_UP = 16 * 128, I_OUT = 16 * 32, I_DN = 64 * 32;
    for (int it = gw; it < I_UP + I_OUT + I_DN; it += nw) {
        if (it < I_UP) p0_transpose_item(P.w_up + (size_t)D * FF, D, FF, (bf16*)(P.ws + WS_UP1), P.norm_mlp + D, scr, it, lane);
        else if (it < I_UP + I_OUT) p0_transpose_item(P.swa_w_out, D, D, (bf16*)(P.ws + WS_SWO), nullptr, scr, it - I_UP, lane);
        else p0_transpose_item(P.w_down + (size_t)D * FF, FF, D, (bf16*)(P.ws + WS_DN1), nullptr, scr, it - I_UP - I_OUT, lane);
    }
}

DI void load64(const bf16* p, float (&v)[64]) {
#pragma unroll
    for (int c = 0; c < 8; ++c) { const v4u u = ((const v4u*)p)[c];
        v[8 * c + 0] = bf_lo(u.x); v[8 * c + 1] = bf_hi(u.x); v[8 * c + 2] = bf_lo(u.y); v[8 * c + 3] = bf_hi(u.y);
        v[8 * c + 4] = bf_lo(u.z); v[8 * c + 5] = bf_hi(u.z); v[8 * c + 6] = bf_lo(u.w); v[8 * c + 7] = bf_hi(u.w); }
}
DI void store64(bf16* p, const float (&v)[64]) {
#pragma unroll
    for (int c = 0; c < 8; ++c) { v4u u; u.x = pk2(v[8 * c], v[8 * c + 1]); u.y = pk2(v[8 * c + 2], v[8 * c + 3]); u.z = pk2(v[8 * c + 4], v[8 * c + 5]); u.w = pk2(v[8 * c + 6], v[8 * c + 7]); ((v4u*)p)[c] = u; }
}
DI void ret_rope(bf16* p, bf16* dstp, const float* t, float sc) {
    float v[64]; load64(p, v);
#pragma unroll
    for (int i4 = 0; i4 < 8; ++i4) { const f32x4 c4 = ((const f32x4*)t)[i4], s4 = ((const f32x4*)t)[8 + i4];
#pragma unroll
        for (int e = 0; e < 4; ++e) { const int i = 4 * i4 + e; const float x1 = v[i], x2 = v[i + 32]; v[i] = (x1 * c4[e] - x2 * s4[e]) * sc; v[i + 32] = (x2 * c4[e] + x1 * s4[e]) * sc; } }
    store64(dstp, v);
}
DI void norm_rope(bf16* p, bf16* dstp, const float* t, const float* g, float sc) {
    float v[64]; load64(p, v);
    float ss = 0.f;
#pragma unroll
    for (int i = 0; i < 64; ++i) ss += v[i] * v[i];
    const float r = 1.0f / sqrtf(ss * (1.0f / 64.0f) + EPS);
#pragma unroll
    for (int i4 = 0; i4 < 16; ++i4) { const f32x4 g4 = ((const f32x4*)g)[i4];
#pragma unroll
        for (int e = 0; e < 4; ++e) v[4 * i4 + e] = v[4 * i4 + e] * r * g4[e]; }
#pragma unroll
    for (int i4 = 0; i4 < 2; ++i4) { const f32x4 c4 = ((const f32x4*)t)[i4], s4 = ((const f32x4*)t)[2 + i4];
#pragma unroll
        for (int e = 0; e < 4; ++e) { const int i = 4 * i4 + e; const float x1 = v[i], x2 = v[i + 8]; v[i] = x1 * c4[e] - x2 * s4[e]; v[i + 8] = x2 * c4[e] + x1 * s4[e]; } }
#pragma unroll
    for (int i = 0; i < 64; ++i) v[i] *= sc;
    store64(dstp, v);
}
DI void post0(const Ptrs& P, bool dry) {
    bf16* junk = (bf16*)(P.ws + WS_OP);
    bf16* proj = (bf16*)(P.ws + WS_PROJ); const float* ropeR = (const float*)(P.ws + WS_ROPER); const float* ropeD = (const float*)(P.ws + WS_ROPED);
    const int gt = blockIdx.x * NTHR + threadIdx.x, NGT = gridDim.x * NTHR;
    for (int it = gt; it < M * 24; it += NGT) {
        const int m = it / 24, slot = it % 24;
        if (slot < 8) ret_rope(proj + (size_t)m * NIN + 64 * slot, dry ? junk + (size_t)it * 64 : proj + (size_t)m * NIN + 64 * slot, ropeR + (size_t)m * 64, slot >= 4 ? 0.125f : 1.0f);
        else norm_rope(proj + (size_t)m * NIN + 1024 + 64 * slot, dry ? junk + (size_t)it * 64 : proj + (size_t)m * NIN + 1024 + 64 * slot, ropeD + (size_t)m * 16, slot < 16 ? P.dq_gain : P.dk_gain, slot < 16 ? QSCALE : 1.0f);
    }
}
DI void post1(const Ptrs& P, bool dry) {
    bf16* junk = (bf16*)(P.ws + WS_OP);
    bf16* proj = (bf16*)(P.ws + WS_PROJ); const float* ropeD = (const float*)(P.ws + WS_ROPED);
    const int gt = blockIdx.x * NTHR + threadIdx.x, NGT = gridDim.x * NTHR;
    for (int it = gt; it < M * 20; it += NGT) {
        const int m = it / 20, slot = it % 20;
        norm_rope(proj + (size_t)m * NQKV + 64 * slot, dry ? junk + (size_t)it * 64 : proj + (size_t)m * NQKV + 64 * slot, ropeD + (size_t)m * 16, slot < 16 ? P.sq_gain : P.sk_gain, slot < 16 ? QSCALE : 1.0f);
    }
}

DI void lds_barrier() { asm volatile("s_waitcnt lgkmcnt(0)" ::: "memory"); __builtin_amdgcn_s_barrier(); asm volatile("" ::: "memory"); }

template <bool STRICT0, bool SINK>
DI void banded_wave(const bf16x8 (&qf)[4], const LAS unsigned char* kb, unsigned vaddr, unsigned vh, int jlo, float sinkv, int n, int hl, f32x16 (&o)[2], float& m_out, float& den_out) {
    f32x16 st[5];
#pragma unroll
    for (int j = 0; j < 5; ++j) {
        f32x16 c;
#pragma unroll
        for (int i = 0; i < 16; ++i) c[i] = 0.f;
#pragma unroll
        for (int s = 0; s < 4; ++s) { const bf16x8 a = *(const LAS bf16x8*)(kb + (32 * j + n) * 144 + (16 * s + 8 * hl) * 2); c = MFMA32(a, qf[s], c); }
        st[j] = c;
    }
    const float NINF = -__builtin_inff();
    float mx = NINF;
#pragma unroll
    for (int j = 0; j < 5; ++j) {
        const bool dead = j < jlo;
#pragma unroll
        for (int i = 0; i < 16; ++i) {
            const int t = crow(i, hl);
            bool ok = !dead;
            if (j == 0) ok = ok && (STRICT0 ? (t > n) : (t >= n));
            if (j == 4) ok = ok && (t <= n);
            const float v = ok ? st[j][i] : NINF;
            st[j][i] = v; mx = fmaxf(mx, v);
        }
    }
    mx = fmaxf(mx, __shfl_xor(mx, 32));
    if (SINK) mx = fmaxf(mx, sinkv);
    float den = 0.f;
#pragma unroll
    for (int j = 0; j < 5; ++j)
#pragma unroll
        for (int i = 0; i < 16; ++i) { const float p = __builtin_amdgcn_exp2f(st[j][i] - mx); st[j][i] = p; den += p; }
    den += __shfl_xor(den, 32);
    if (SINK) den += __builtin_amdgcn_exp2f(sinkv - mx);
#pragma unroll
    for (int i = 0; i < 16; ++i) { o[0][i] = 0.f; o[1][i] = 0.f; }
#pragma unroll
    for (int j = 0; j < 5; ++j)
#pragma unroll
        for (int s2 = 0; s2 < 2; ++s2) {
            const bf16x8 pf = pack8(st[j], s2);
            s16x4 a0l, a0h, a1l, a1h;
            const unsigned ad = vaddr + (32 * j + 16 * s2) * 64;
            TR4(a0l, a0h, a1l, a1h, ad, ad + vh);
            o[0] = MFMA32(cat4(a0l, a0h), pf, o[0]); o[1] = MFMA32(cat4(a1l, a1h), pf, o[1]);
        }
    m_out = mx; den_out = den;
}

struct DilU { int p, b, h, sh, res, qb; };
DI DilU dil_decode(int u) { DilU d; d.p = u % 3; const int rem = u / 3; d.b = rem >> 7; d.h = (rem >> 4) & 7; const int idx16 = rem & 15; d.sh = 2 * d.p; d.res = idx16 & ((1 << d.sh) - 1); d.qb = idx16 >> d.sh; return d; }
DI void dil_issue(const DilU& d, const bf16* proj, int tid, int wave, int lane, v4u (&kreg)[6], v4u (&vreg)[6], bf16x8 (&qf)[4]) {
    const int l0 = 256 * d.qb; const size_t tokbase = (size_t)d.b * SEQ;
#pragma unroll
    for (int c = 0; c < 6; ++c) {
        const int id = tid + 512 * c, row = id >> 3, ch = id & 7, l = l0 - 128 + row;
        if (l >= 0) { const bf16* src = proj + (tokbase + ((size_t)l << d.sh) + d.res) * NIN + d.h * 64 + ch * 8;
            kreg[c] = *(const v4u*)(src + 2048); vreg[c] = *(const v4u*)(src + 2560); }
        else { kreg[c] = (v4u){0u, 0u, 0u, 0u}; vreg[c] = (v4u){0u, 0u, 0u, 0u}; }
    }
    const int ql = l0 + 32 * wave + (lane & 31);
    const bf16* qs = proj + (tokbase + ((size_t)ql << d.sh) + d.res) * NIN + 1536 + d.h * 64 + 8 * (lane >> 5);
#pragma unroll
    for (int s = 0; s < 4; ++s) qf[s] = *(const bf16x8*)(qs + 16 * s);
}
DI void dil_phase(const Ptrs& P, LAS unsigned char* lds, int tid, int wave, int lane) {
    const bf16* proj = (const bf16*)(P.ws + WS_PROJ);
    bf16* op = (bf16*)(P.ws + WS_OP); float* lse = (float*)(P.ws + WS_LSE);
    constexpr unsigned KOFF = 0, VOFF = 384 * 144, VH = 384 * 64;
    int u = blockIdx.x; if (u >= 1536) return;
    const int n = lane & 31, hl = lane >> 5;
    const int i16 = lane & 15, q4 = i16 >> 2, p4 = i16 & 3, g16 = (lane >> 4) & 1;
    const unsigned vaddr = lds_addr(lds + VOFF) + (32 * wave + 4 * hl + q4) * 64 + (16 * g16 + 4 * p4) * 2;
    v4u kreg[6], vreg[6]; bf16x8 qn[4];
    DilU d = dil_decode(u);
    dil_issue(d, proj, tid, wave, lane, kreg, vreg, qn);
    for (;;) {
#pragma unroll
        for (int c = 0; c < 6; ++c) {
            const int id = tid + 512 * c, row = id >> 3, ch = id & 7;
            *(LAS v4u*)(lds + KOFF + row * 144 + ch * 16) = kreg[c];
            *(LAS v4u*)(lds + VOFF + (ch >> 2) * VH + row * 64 + (ch & 3) * 16) = vreg[c];
        }
        bf16x8 qf[4];
#pragma unroll
        for (int s = 0; s < 4; ++s) qf[s] = qn[s];
        lds_barrier();
        const int un = u + gridDim.x; const bool more = un < 1536;
        const DilU dn = dil_decode(more ? un : u);
        if (more) dil_issue(dn, proj, tid, wave, lane, kreg, vreg, qn);
        const int jlo = (d.qb == 0) ? max(0, 4 - wave) : 0;
        f32x16 o[2]; float mx, den;
        banded_wave<false, false>(qf, lds + KOFF + (32 * wave) * 144, vaddr, VH, jlo, 0.f, n, hl, o, mx, den);
        const float inv = 1.0f / den;
        const size_t qtok = (size_t)d.b * SEQ + ((size_t)(256 * d.qb + 32 * wave + n) << d.sh) + d.res;
        bf16* dst = op + ((size_t)d.p * M + qtok) * 512 + d.h * 64 + 4 * hl;
#pragma unroll
        for (int mt = 0; mt < 2; ++mt)
#pragma unroll
            for (int g = 0; g < 4; ++g) { v2u w; w.x = pk2(o[mt][4 * g] * inv, o[mt][4 * g + 1] * inv); w.y = pk2(o[mt][4 * g + 2] * inv, o[mt][4 * g + 3] * inv);
                *(v2u*)(dst + 32 * mt + 8 * g) = w; }
        if (hl == 0) lse[((size_t)d.p * M + qtok) * 8 + d.h] = (mx + __builtin_amdgcn_logf(den)) * LN2;
        lds_barrier();
        if (!more) break;
        u = un; d = dn;
    }
}

DI void swa_issue(int u, const bf16* proj, int tid, int wave, int lane, v4u (&kreg)[3], v4u (&vreg)[3], bf16x8 (&qf)[4]) {
    const int b = u >> 8, kvh = (u >> 6) & 3, qblk = u & 63, q0 = 64 * qblk;
    const size_t tokbase = (size_t)b * SEQ;
#pragma unroll
    for (int c = 0; c < 3; ++c) {
        const int id = tid + 512 * c, row = id >> 3, ch = id & 7, t = q0 - 128 + row;
        if (t >= 0) { const bf16* src = proj + (tokbase + t) * NQKV + kvh * 64 + ch * 8;
            kreg[c] = *(const v4u*)(src + 1024); vreg[c] = *(const v4u*)(src + 1280); }
        else { kreg[c] = (v4u){0u, 0u, 0u, 0u}; vreg[c] = (v4u){0u, 0u, 0u, 0u}; }
    }
    const int g = wave >> 1, qh = wave & 1, qhead = kvh * 4 + g;
    const bf16* qs = proj + (tokbase + q0 + 32 * qh + (lane & 31)) * NQKV + qhead * 64 + 8 * (lane >> 5);
#pragma unroll
    for (int s = 0; s < 4; ++s) qf[s] = *(const bf16x8*)(qs + 16 * s);
}
DI void swa_phase(const Ptrs& P, LAS unsigned char* lds, int tid, int wave, int lane, int u0, int ustep, int ucnt) {
    const bf16* proj = (const bf16*)(P.ws + WS_PROJ);
    bf16* ao = (bf16*)P.out;
    constexpr unsigned KOFF = 0, VOFF = 192 * 144, VH = 192 * 64;
    int u = u0, left = ucnt; if (left <= 0) return;
    const int n = lane & 31, hl = lane >> 5, g = wave >> 1, qh = wave & 1;
    const int i16 = lane & 15, q4 = i16 >> 2, p4 = i16 & 3, g16 = (lane >> 4) & 1;
    const unsigned vaddr = lds_addr(lds + VOFF) + (32 * qh + 4 * hl + q4) * 64 + (16 * g16 + 4 * p4) * 2;
    v4u kreg[3], vreg[3]; bf16x8 qn[4];
    swa_issue(u, proj, tid, wave, lane, kreg, vreg, qn);
    for (;;) {
#pragma unroll
        for (int c = 0; c < 3; ++c) {
            const int id = tid + 512 * c, row = id >> 3, ch = id & 7;
            *(LAS v4u*)(lds + KOFF + row * 144 + ch * 16) = kreg[c];
            *(LAS v4u*)(lds + VOFF + (ch >> 2) * VH + row * 64 + (ch & 3) * 16) = vreg[c];
        }
        bf16x8 qf[4];
#pragma unroll
        for (int s = 0; s < 4; ++s) qf[s] = qn[s];
        lds_barrier();
        const int un = u + ustep; --left; const bool more = left > 0;
        if (more) swa_issue(un, proj, tid, wave, lane, kreg, vreg, qn);
        const int b = u >> 8, kvh = (u >> 6) & 3, qblk = u & 63, q0 = 64 * qblk, qhead = kvh * 4 + g;
        const int jlo = max(0, 4 - 2 * qblk - qh);
        const float sinkv = P.sinks[qhead] * LOG2E;
        f32x16 o[2]; float mx, den;
        banded_wave<true, true>(qf, lds + KOFF + (32 * qh) * 144, vaddr, VH, jlo, sinkv, n, hl, o, mx, den);
        const float inv = 1.0f / den;
        const size_t qtok = (size_t)b * SEQ + q0 + 32 * qh + n;
        bf16* dst = ao + (qtok >> 8) * 524288 + (qtok & 255) * D + qhead * 64 + 4 * hl;
#pragma unroll
        for (int mt = 0; mt < 2; ++mt)
#pragma unroll
            for (int gg = 0; gg < 4; ++gg) { v2u w; w.x = pk2(o[mt][4 * gg] * inv, o[mt][4 * gg + 1] * inv); w.y = pk2(o[mt][4 * gg + 2] * inv, o[mt][4 * gg + 3] * inv);
                *(v2u*)(dst + 32 * mt + 8 * gg) = w; }
        lds_barrier();
        if (!more) break;
        u = un;
    }
}

DI float ret_lg2(int h) { return __builtin_amdgcn_logf(1.0f - __builtin_amdgcn_exp2f(-5.0f - (float)h)); }
DI void retA_unit(int u, const Ptrs& P, LAS unsigned char* lds, int tid, int wave, int lane) {
    const bf16* proj = (const bf16*)(P.ws + WS_PROJ);
    bf16* sb = (bf16*)(P.ws + WS_SB) + (size_t)u * 8192;
    const int b = u >> 7, h = (u >> 5) & 3, nck = u & 31;
    const float lg2 = ret_lg2(h);
    const size_t tok0 = (size_t)b * SEQ + nck * 128;
    constexpr unsigned VOFF = 0, KOFF = 32768;
    v4u vreg[4], kreg[2];
#pragma unroll
    for (int c = 0; c < 4; ++c) { const int id = tid + 512 * c, row = id >> 4, ch = id & 15; vreg[c] = *(const v4u*)(proj + (tok0 + row) * NIN + 512 + h * 128 + ch * 8); }
#pragma unroll
    for (int c = 0; c < 2; ++c) { const int id = tid + 512 * c, row = id >> 3, ch = id & 7; kreg[c] = *(const v4u*)(proj + (tok0 + row) * NIN + 256 + h * 64 + ch * 8); }
#pragma unroll
    for (int c = 0; c < 4; ++c) { const int id = tid + 512 * c, row = id >> 4, ch = id & 15; *(LAS v4u*)(lds + VOFF + (ch >> 2) * 8192 + row * 64 + (ch & 3) * 16) = vreg[c]; }
#pragma unroll
    for (int c = 0; c < 2; ++c) { const int id = tid + 512 * c, row = id >> 3, ch = id & 7;
        const float z = __builtin_amdgcn_exp2f((float)(127 - row) * lg2);
        v4u k = kreg[c], w;
        w.x = pk2(bf_lo(k.x) * z, bf_hi(k.x) * z); w.y = pk2(bf_lo(k.y) * z, bf_hi(k.y) * z); w.z = pk2(bf_lo(k.z) * z, bf_hi(k.z) * z); w.w = pk2(bf_lo(k.w) * z, bf_hi(k.w) * z);
        *(LAS v4u*)(lds + KOFF + (ch >> 2) * 8192 + row * 64 + (ch & 3) * 16) = w; }
    lds_barrier();
    const int n = lane & 31, hl = lane >> 5, mt = wave >> 1, nt = wave & 1;
    const int i16 = lane & 15, q4 = i16 >> 2, p4 = i16 & 3, g16 = (lane >> 4) & 1;
    const unsigned lo = (8 * hl + q4) * 64 + (16 * g16 + 4 * p4) * 2;
    const unsigned va = lds_addr(lds + VOFF) + mt * 8192 + lo, ka = lds_addr(lds + KOFF) + nt * 8192 + lo;
    f32x16 acc;
#pragma unroll
    for (int i = 0; i < 16; ++i) acc[i] = 0.f;
#pragma unroll
    for (int s = 0; s < 8; ++s) {
        s16x4 al, ah, bl, bh;
        TR4N(al, ah, bl, bh, va + s * 1024, ka + s * 1024);
        acc = MFMA32(cat4(al, ah), cat4(bl, bh), acc);
    }
#pragma unroll
    for (int i = 0; i < 16; ++i) sb[(32 * mt + crow(i, hl)) * 64 + 32 * nt + n] = (bf16)(pk2(acc[i], 0.f) & 0xffffu);
    lds_barrier();
}

DI void retB_unit(int u, const Ptrs& P, LAS unsigned char* lds, int tid, int wave, int lane, float (&R)[2][8], bool have, bool carry) {
    const bf16* proj = (const bf16*)(P.ws + WS_PROJ);
    bf16* mixed = (bf16*)P.out;
    const int b = u >> 7, h = (u >> 5) & 3, nck = u & 31;
    const float lg2 = ret_lg2(h);
    const size_t tok0 = (size_t)b * SEQ + nck * 128;
    constexpr unsigned KOFF = 0, VOFF = 18432, ROFF = 51200;
    v4u vreg[4], kreg[2];
#pragma unroll
    for (int c = 0; c < 4; ++c) { const int id = tid + 512 * c, row = id >> 4, ch = id & 15; vreg[c] = *(const v4u*)(proj + (tok0 + row) * NIN + 512 + h * 128 + ch * 8); }
#pragma unroll
    for (int c = 0; c < 2; ++c) { const int id = tid + 512 * c, row = id >> 3, ch = id & 7; kreg[c] = *(const v4u*)(proj + (tok0 + row) * NIN + 256 + h * 64 + ch * 8); }
    const int n = lane & 31, hl = lane >> 5, qg = wave >> 1, dvh = wave & 1;
    bf16x8 qf[4];
    { const bf16* qs = proj + (tok0 + 32 * qg + n) * NIN + h * 64 + 8 * hl;
#pragma unroll
      for (int s = 0; s < 4; ++s) qf[s] = *(const bf16x8*)(qs + 16 * s); }
    v4u gate[4];
    { const bf16* gp = proj + (tok0 + (tid >> 2)) * NIN + 1024 + h * 128 + 32 * (tid & 3);
#pragma unroll
      for (int k8 = 0; k8 < 4; ++k8) gate[k8] = ((const v4u*)gp)[k8]; }
    const float cd = __builtin_amdgcn_exp2f(128.0f * lg2);
    v4u own[2];
    if (carry) { const v4u* so = (const v4u*)((const bf16*)(P.ws + WS_SB) + (size_t)u * 8192) + tid; own[0] = so[0]; own[1] = so[512]; }
    if (!have) {
#pragma unroll
        for (int j = 0; j < 2; ++j)
#pragma unroll
            for (int e = 0; e < 8; ++e) R[j][e] = 0.f;
        const v4u* sp = (const v4u*)((const bf16*)(P.ws + WS_SB) + (size_t)(u - nck) * 8192) + tid;
        for (int m0 = 0; m0 < nck; m0 += 8) {
            v4u t[8][2];
#pragma unroll
            for (int q = 0; q < 8; ++q) { const int mm = min(m0 + q, nck - 1);
#pragma unroll
                for (int j = 0; j < 2; ++j) t[q][j] = sp[(size_t)mm * 1024 + 512 * j]; }
#pragma unroll
            for (int q = 0; q < 8; ++q) if (m0 + q < nck) {
#pragma unroll
                for (int j = 0; j < 2; ++j) { const v4u x = t[q][j];
                    R[j][0] = R[j][0] * cd + bf_lo(x.x); R[j][1] = R[j][1] * cd + bf_hi(x.x); R[j][2] = R[j][2] * cd + bf_lo(x.y); R[j][3] = R[j][3] * cd + bf_hi(x.y);
                    R[j][4] = R[j][4] * cd + bf_lo(x.z); R[j][5] = R[j][5] * cd + bf_hi(x.z); R[j][6] = R[j][6] * cd + bf_lo(x.w); R[j][7] = R[j][7] * cd + bf_hi(x.w); } }
        }
    }
#pragma unroll
    for (int j = 0; j < 2; ++j) { const int e = (tid + 512 * j) * 8, dv = e >> 6, dk = e & 63;
        v4u w; w.x = pk2(R[j][0], R[j][1]); w.y = pk2(R[j][2], R[j][3]); w.z = pk2(R[j][4], R[j][5]); w.w = pk2(R[j][6], R[j][7]);
        *(LAS v4u*)(lds + ROFF + dv * 144 + dk * 2) = w; }
    if (carry) {
#pragma unroll
        for (int j = 0; j < 2; ++j) { const v4u x = own[j];
            R[j][0] = R[j][0] * cd + bf_lo(x.x); R[j][1] = R[j][1] * cd + bf_hi(x.x); R[j][2] = R[j][2] * cd + bf_lo(x.y); R[j][3] = R[j][3] * cd + bf_hi(x.y);
            R[j][4] = R[j][4] * cd + bf_lo(x.z); R[j][5] = R[j][5] * cd + bf_hi(x.z); R[j][6] = R[j][6] * cd + bf_lo(x.w); R[j][7] = R[j][7] * cd + bf_hi(x.w); }
    }
#pragma unroll
    for (int c = 0; c < 4; ++c) { const int id = tid + 512 * c, row = id >> 4, ch = id & 15; *(LAS v4u*)(lds + VOFF + (ch >> 2) * 8192 + row * 64 + (ch & 3) * 16) = vreg[c]; }
#pragma unroll
    for (int c = 0; c < 2; ++c) { const int id = tid + 512 * c, row = id >> 3, ch = id & 7; *(LAS v4u*)(lds + KOFF + row * 144 + ch * 16) = kreg[c]; }
    lds_barrier();
    f32x16 o[2];
#pragma unroll
    for (int mt = 0; mt < 2; ++mt) {
        f32x16 c;
#pragma unroll
        for (int i = 0; i < 16; ++i) c[i] = 0.f;
#pragma unroll
        for (int s = 0; s < 4; ++s) { const bf16x8 a = *(const LAS bf16x8*)(lds + ROFF + (64 * dvh + 32 * mt + n) * 144 + (16 * s + 8 * hl) * 2); c = MFMA32(a, qf[s], c); }
        const float xi = __builtin_amdgcn_exp2f((float)(32 * qg + n + 1) * lg2);
#pragma unroll
        for (int i = 0; i < 16; ++i) c[i] *= xi;
        o[mt] = c;
    }
    const int i16 = lane & 15, q4 = i16 >> 2, p4 = i16 & 3, g16 = (lane >> 4) & 1;
    const unsigned vaddr = lds_addr(lds + VOFF) + (2 * dvh) * 8192 + (4 * hl + q4) * 64 + (16 * g16 + 4 * p4) * 2;
    for (int j = 0; j <= qg; ++j) {
        f32x16 st;
#pragma unroll
        for (int i = 0; i < 16; ++i) st[i] = 0.f;
#pragma unroll
        for (int s = 0; s < 4; ++s) { const bf16x8 a = *(const LAS bf16x8*)(lds + KOFF + (32 * j + n) * 144 + (16 * s + 8 * hl) * 2); st = MFMA32(a, qf[s], st); }
#pragma unroll
        for (int i = 0; i < 16; ++i) { const int diff = 32 * (qg - j) + n - crow(i, hl); st[i] = diff >= 0 ? st[i] * __builtin_amdgcn_exp2f((float)diff * lg2) : 0.f; }
#pragma unroll
        for (int s2 = 0; s2 < 2; ++s2) {
            const bf16x8 pf = pack8(st, s2);
            s16x4 a0l, a0h, a1l, a1h;
            const unsigned ad = vaddr + (32 * j + 16 * s2) * 64;
            TR4(a0l, a0h, a1l, a1h, ad, ad + 8192);
            o[0] = MFMA32(cat4(a0l, a0h), pf, o[0]); o[1] = MFMA32(cat4(a1l, a1h), pf, o[1]);
        }
    }
    lds_barrier();
    LAS float* ot = (LAS float*)lds;
#pragma unroll
    for (int mt = 0; mt < 2; ++mt)
#pragma unroll
        for (int i = 0; i < 16; ++i) ot[(32 * qg + n) * 129 + 64 * dvh + 32 * mt + crow(i, hl)] = o[mt][i];
    lds_barrier();
    {
        const int c = tid >> 2, sg = tid & 3;
        float v[32]; float s = 0.f;
#pragma unroll
        for (int k = 0; k < 32; ++k) { v[k] = ot[c * 129 + 32 * sg + k]; s += v[k]; }
        s += __shfl_xor(s, 1); s += __shfl_xor(s, 2);
        const float mu = s * (1.0f / 128.0f);
        float q = 0.f;
#pragma unroll
        for (int k = 0; k < 32; ++k) { v[k] -= mu; q += v[k] * v[k]; }
        q += __shfl_xor(q, 1); q += __shfl_xor(q, 2);
        const float rs = 1.0f / sqrtf(q * (1.0f / 128.0f) + EPS);
        f32x4 gnv[8];
#pragma unroll
        for (int k4 = 0; k4 < 8; ++k4) gnv[k4] = *(const f32x4*)(P.gn_gain + h * 128 + 32 * sg + 4 * k4);
        bf16* dst = mixed + ((tok0 + c) >> 8) * 524288 + ((tok0 + c) & 255) * D + h * 128 + 32 * sg;
#pragma unroll
        for (int k8 = 0; k8 < 4; ++k8) {
            const v4u gu = gate[k8];
            float g[8] = {bf_lo(gu.x), bf_hi(gu.x), bf_lo(gu.y), bf_hi(gu.y), bf_lo(gu.z), bf_hi(gu.z), bf_lo(gu.w), bf_hi(gu.w)};
            float r[8];
#pragma unroll
            for (int e = 0; e < 8; ++e) { const float gate = g[e] / (1.0f + __expf(-g[e])); r[e] = v[8 * k8 + e] * rs * gnv[2 * k8 + (e >> 2)][e & 3] * gate; }
            v4u w; w.x = pk2(r[0], r[1]); w.y = pk2(r[2], r[3]); w.z = pk2(r[4], r[5]); w.w = pk2(r[6], r[7]);
            ((v4u*)dst)[k8] = w;
        }
    }
    lds_barrier();
}
DI void dil_combine(const Ptrs& P, int tokb, int nitems, int gt, int NGT) {
    const bf16* op = (const bf16*)(P.ws + WS_OP); const float* lse = (const float*)(P.ws + WS_LSE); bf16* mixed = (bf16*)P.out;
    for (int it = gt; it < nitems; it += NGT) {
        const int tok = tokb + (it >> 6), hh = (it >> 3) & 7, ch = it & 7;
        const float l0 = lse[((size_t)0 * M + tok) * 8 + hh], l1 = lse[((size_t)1 * M + tok) * 8 + hh], l2 = lse[((size_t)2 * M + tok) * 8 + hh];
        const float mx = fmaxf(l0, fmaxf(l1, l2));
        float w0 = __expf(l0 - mx), w1 = __expf(l1 - mx), w2 = __expf(l2 - mx);
        const float inv = 1.0f / (w0 + w1 + w2); w0 *= inv; w1 *= inv; w2 *= inv;
        const v4u a = *(const v4u*)(op + ((size_t)0 * M + tok) * 512 + hh * 64 + ch * 8);
        const v4u bb = *(const v4u*)(op + ((size_t)1 * M + tok) * 512 + hh * 64 + ch * 8);
        const v4u c = *(const v4u*)(op + ((size_t)2 * M + tok) * 512 + hh * 64 + ch * 8);
        v4u w;
        w.x = pk2(w0 * bf_lo(a.x) + w1 * bf_lo(bb.x) + w2 * bf_lo(c.x), w0 * bf_hi(a.x) + w1 * bf_hi(bb.x) + w2 * bf_hi(c.x));
        w.y = pk2(w0 * bf_lo(a.y) + w1 * bf_lo(bb.y) + w2 * bf_lo(c.y), w0 * bf_hi(a.y) + w1 * bf_hi(bb.y) + w2 * bf_hi(c.y));
        w.z = pk2(w0 * bf_lo(a.z) + w1 * bf_lo(bb.z) + w2 * bf_lo(c.z), w0 * bf_hi(a.z) + w1 * bf_hi(bb.z) + w2 * bf_hi(c.z));
        w.w = pk2(w0 * bf_lo(a.w) + w1 * bf_lo(bb.w) + w2 * bf_lo(c.w), w0 * bf_hi(a.w) + w1 * bf_hi(bb.w) + w2 * bf_hi(c.w));
        *(v4u*)(mixed + (size_t)(tok >> 8) * 524288 + (size_t)(tok & 255) * D + 512 + hh * 64 + ch * 8) = w;
    }
}

#define XB_TMO      128
#define XB_XCNT(j)  (256  + 64 * (j))
#define XB_XSUB(j)  (1280 + 64 * (j))
#define XB_XGEN(j)  (2304 + 64 * (j))
#define XB_TOP      3328
#define XB_TOPGEN   3392
#define XCD_BAR_WORDS 3456
#define XB_SPIN_CAP (1u << 18)

__device__ __forceinline__ unsigned xb_ld(unsigned* p)              { return __hip_atomic_load(p, __ATOMIC_RELAXED, __HIP_MEMORY_SCOPE_AGENT); }
__device__ __forceinline__ unsigned xb_add(unsigned* p, unsigned v) { return __hip_atomic_fetch_add(p, v, __ATOMIC_RELAXED, __HIP_MEMORY_SCOPE_AGENT); }
__device__ __forceinline__ unsigned xb_xcc_id() { return (unsigned)__builtin_amdgcn_s_getreg((3 << 11) | 20) & 0xFu; }
#define XB_SPIN(cond, bar) do { unsigned _sp = 0; while (cond) { __builtin_amdgcn_s_sleep(1); \
    if ((++_sp & 255u) == 0u) { if (xb_ld(&(bar)[XB_TMO])) break; if (_sp > XB_SPIN_CAP) { atomicAdd(&(bar)[XB_TMO], 1u); break; } } } } while (0)

struct XcdBarrier {
    unsigned* bar; unsigned x;
    volatile LAS unsigned* st;
};

__device__ __forceinline__ XcdBarrier xcd_barrier_post(unsigned* bar, volatile LAS unsigned* st) {
    XcdBarrier b; b.bar = bar; b.x = xb_xcc_id(); b.st = st;
    if (threadIdx.x == 0) (void)xb_add(&bar[XB_XCNT(b.x)], 1u);
    return b;
}
__device__ __forceinline__ void xcd_barrier_complete(unsigned* bar, unsigned x, unsigned& nloc, unsigned& nx) {
    const unsigned G = gridDim.x * gridDim.y * gridDim.z;
    unsigned sum, cnt, mine, sp = 0u;
    for (;;) {
        sum = 0u; cnt = 0u; mine = 0u;
#pragma unroll
        for (unsigned j = 0; j < 16; ++j) { const unsigned c = xb_ld(&bar[XB_XCNT(j)]); sum += c; cnt += (c > 0u) ? 1u : 0u; mine = (j == x) ? c : mine; }
        if (sum == G) break;
        __builtin_amdgcn_s_sleep(1);
        if ((++sp & 255u) == 0u) { if (xb_ld(&bar[XB_TMO])) break; if (sp > XB_SPIN_CAP) { atomicAdd(&bar[XB_TMO], 1u); break; } }
    }
    nloc = mine > 0u ? mine : 1u; nx = cnt > 0u ? cnt : 1u;
}

__device__ __forceinline__ void xcd_barrier(const XcdBarrier& b) {
    asm volatile("s_waitcnt vmcnt(0)" ::: "memory");
    __syncthreads();
    if (threadIdx.x == 0) {
        unsigned* bar = b.bar;
        __builtin_amdgcn_s_waitcnt(0);
        unsigned nloc = b.st[0], nx = b.st[1];
        if (nloc == 0u) { xcd_barrier_complete(bar, b.x, nloc, nx); b.st[0] = nloc; b.st[1] = nx; }
        const unsigned old = xb_add(&bar[XB_XSUB(b.x)], 1u);
        const unsigned gen = old / nloc;
        if (old + 1u == (gen + 1u) * nloc) {
            __builtin_amdgcn_fence(__ATOMIC_RELEASE, "agent");
            asm volatile("s_waitcnt vmcnt(0)" ::: "memory");
            const unsigned og = xb_add(&bar[XB_TOP], 1u);
            const unsigned tg = og / nx;
            if (og + 1u == (tg + 1u) * nx) xb_add(&bar[XB_TOPGEN], 1u);
            else XB_SPIN(xb_ld(&bar[XB_TOPGEN]) == tg, bar);
            __builtin_amdgcn_fence(__ATOMIC_ACQUIRE, "agent");
            xb_add(&bar[XB_XGEN(b.x)], 1u);
            asm volatile("s_waitcnt vmcnt(0)" ::: "memory");
        } else {
            XB_SPIN(xb_ld(&bar[XB_XGEN(b.x)]) == gen, bar);
            __builtin_amdgcn_fence(__ATOMIC_ACQUIRE, "agent");
            asm volatile("s_waitcnt vmcnt(0)" ::: "memory");
        }
    }
    __syncthreads();
}

struct Args { const float* in[17]; float* out; unsigned char* ws; int ph_lo, ph_hi, rep_mask, sync_rep; };
constexpr int NPHASE = 6;

template <class Epi> DI void run_gemm(LAS unsigned char* lds, const bf16* A, const bf16* Bt, int N, int K, const Epi& E) {
    pg8::Gemm g{A, Bt, M, N, K}; pg8::StaticOrder S; S.init(M, N, (int)gridDim.x, (int)blockIdx.x);
    pg8::gemm_phase<Epi, pg8::StaticOrder, true, true>(lds, g, S, E);
}


struct GroupOrder {
    int pm, pn0, step, cnt;
    __device__ __forceinline__ bool next(int i, pg8::Unit& u) const { if (i >= cnt) return false; u.pm = pm; u.pn = pn0 + i * step; return true; }
    __device__ __forceinline__ void a_ready(const pg8::Unit&) const {}
    __device__ __forceinline__ void done(const pg8::Unit&) const {}
};
DI void group_sync(unsigned* cnt, unsigned target, bool same_xcd) {
    asm volatile("s_waitcnt vmcnt(0)" ::: "memory");
    __syncthreads();
    if (threadIdx.x == 0) {
        if (!same_xcd) {
            __builtin_amdgcn_fence(__ATOMIC_RELEASE, "agent");
            asm volatile("s_waitcnt vmcnt(0)" ::: "memory");
        }
        (void)xb_add(cnt, 1u);
        unsigned sp = 0u;
        while (xb_ld(cnt) < target) { __builtin_amdgcn_s_sleep(1); if (++sp > (1u << 22)) break; }
        __builtin_amdgcn_fence(__ATOMIC_ACQUIRE, "agent");
        asm volatile("s_waitcnt vmcnt(0)" ::: "memory");
    }
    __syncthreads();
}
template <class Epi> DI void run_gemm_g(LAS unsigned char* lds, const bf16* A, const bf16* Bt, int N, int K, const GroupOrder& S, const Epi& E) {
    pg8::Gemm g{A, Bt, M, N, K};
    pg8::gemm_phase<Epi, GroupOrder, true, true>(lds, g, S, E);
}

__global__ void __launch_bounds__(NTHR, 2) mega_fwd(Args args) {
    extern __shared__ __attribute__((aligned(16))) unsigned char lds_raw[];
    LAS unsigned char* lds = (LAS unsigned char*)lds_raw;
    cg::grid_group grid = cg::this_grid();
    const int tid = threadIdx.x, lane = tid & 63, wave = __builtin_amdgcn_readfirstlane(tid >> 6);
    Ptrs P;
    P.x = args.in[0]; P.pos = (const int*)args.in[1]; P.norm_mix = args.in[2]; P.norm_mlp = args.in[3]; P.w_up = args.in[4]; P.w_down = args.in[5];
    P.w_in = args.in[6]; P.w_out = args.in[7]; P.gn_gain = args.in[8]; P.dq_gain = args.in[9]; P.dk_gain = args.in[10]; P.w_qkv = args.in[11];
    P.b_qkv = args.in[12]; P.swa_w_out = args.in[13]; P.sq_gain = args.in[14]; P.sk_gain = args.in[15]; P.sinks = args.in[16];
    P.out = args.out; P.ws = args.ws;
    unsigned char* ws = args.ws;
    float* ss = (float*)(ws + WS_SS);
    const int lo = args.ph_lo, hi = args.ph_hi; const int dryv = args.rep_mask;
    if (lo < 0) grid.sync();
    volatile LAS unsigned* MISC = (volatile LAS unsigned*)(lds + 131072 + 64);
    if (tid < 32) MISC[tid] = 0u;
    __syncthreads();
    XcdBarrier bar; bar.bar = (unsigned*)(ws + WS_BAR); bar.x = 0; bar.st = MISC + 8;
    if (hi - lo > 1) bar = xcd_barrier_post((unsigned*)(ws + WS_BAR), MISC + 8);
    if (tid == 0) __hip_atomic_store((unsigned*)(ws + WS_XID) + blockIdx.x, xb_xcc_id() + 1u, __ATOMIC_RELAXED, __HIP_MEMORY_SCOPE_AGENT);
#define IN(k) (lo <= (k) && (k) < hi)
#define SEAM(k) do { if (IN(k) && IN((k) + 1)) { for (int sr_ = 0; sr_ < srep; ++sr_) xcd_barrier(bar); } } while (0)
#if SYNC_REP != 1
    const int srep = args.sync_rep;
#else
    constexpr int srep = 1;
#endif

    if (IN(0)) { p0_prologue(P, lds, wave, lane); __syncthreads(); }
    SEAM(0);
    if (IN(1)) {
        EpiProj<0> E{(bf16*)(ws + WS_PROJ), ss, nullptr, (const float*)(ws + WS_ROPER), (const float*)(ws + WS_ROPED), P.dq_gain, P.dk_gain};
        run_gemm(lds, (const bf16*)(ws + WS_XA), (const bf16*)(ws + WS_WIN), NIN, D, E);
    }
    SEAM(1);
    if (IN(2)) {
        dil_phase(P, lds, tid, wave, lane);
        for (int u = blockIdx.x; u < 512; u += gridDim.x) retA_unit(u, P, lds, tid, wave, lane);
    }
    SEAM(2);
    const int gxcd = blockIdx.x & 7, gq = blockIdx.x >> 3, gslot = gq >> 2, grp_id = gxcd + 8 * gslot, mi = gq & 3;
    unsigned* gcnt = (unsigned*)(ws + WS_GRP) + 64 * grp_id;
    bool same_xcd = false;
    if (lo <= 0 && hi >= 4) {
        const unsigned* xid = (const unsigned*)(ws + WS_XID) + gxcd + 32 * gslot;
        const unsigned i0 = __hip_atomic_load(xid, __ATOMIC_RELAXED, __HIP_MEMORY_SCOPE_AGENT), i1 = __hip_atomic_load(xid + 8, __ATOMIC_RELAXED, __HIP_MEMORY_SCOPE_AGENT);
        const unsigned i2 = __hip_atomic_load(xid + 16, __ATOMIC_RELAXED, __HIP_MEMORY_SCOPE_AGENT), i3 = __hip_atomic_load(xid + 24, __ATOMIC_RELAXED, __HIP_MEMORY_SCOPE_AGENT);
        same_xcd = (i0 != 0u) && (i0 == i1) && (i0 == i2) && (i0 == i3);
    }
    if (IN(3)) {
        { float R[2][8];
          const int uA = (grp_id >> 4) * 128 + mi * 32 + 2 * (grp_id & 15);
          retB_unit(uA, P, lds, tid, wave, lane, R, false, true);
          retB_unit(uA + 1, P, lds, tid, wave, lane, R, true, false);
          dil_combine(P, 256 * grp_id, 256 * 64, mi * NTHR + tid, 4 * NTHR); }
        group_sync(gcnt, 4u, same_xcd);
        unsigned* rdone = (unsigned*)(ws + WS_BAR) + 3584;
        if (tid == 0) (void)xb_add(rdone, 1u);
        { EpiResid<true, false, false> E{nullptr, (const bf16*)(ws + WS_XA), nullptr, (bf16*)(ws + WS_XB), ss + M, dryv, 1, rdone, gridDim.x}; GroupOrder S{2 * grp_id, mi, 1, 1};
          run_gemm_g(lds, (const bf16*)P.out, (const bf16*)(ws + WS_WOUT), D, D, S, E); }
        group_sync(gcnt, 8u, same_xcd);
        { EpiRowScale<1, false> E{(bf16*)(ws + WS_HID), FF, ss + M, nullptr}; GroupOrder S{grp_id, 4 * mi, 1, 4};
          run_gemm_g(lds, (const bf16*)(ws + WS_XB), (const bf16*)(ws + WS_UP0), FF, D, S, E); }
        group_sync(gcnt, 12u, same_xcd);
        { EpiResid<true, false, false> E{nullptr, (const bf16*)(ws + WS_XB), nullptr, (bf16*)(ws + WS_XA), ss + 2 * M, dryv, 0, nullptr, 0u}; GroupOrder S{grp_id, mi, 1, 1};
          run_gemm_g(lds, (const bf16*)(ws + WS_HID), (const bf16*)(ws + WS_DN0), D, FF, S, E); }
    }
    SEAM(3);
    if (IN(4)) {
        EpiProj<1> E{(bf16*)(ws + WS_PROJ), ss + 2 * M, P.b_qkv, nullptr, (const float*)(ws + WS_ROPED), P.sq_gain, P.sk_gain};
        run_gemm(lds, (const bf16*)(ws + WS_XA), (const bf16*)(ws + WS_QKV), NQKV, D, E);
        if (gridDim.x == 256 && blockIdx.x >= 128) { __syncthreads(); p0_late(P, lds, wave, lane, 128); }
        else if (gridDim.x != 256) { __syncthreads(); p0_late(P, lds, wave, lane, 0); }
    }
    SEAM(4);
    if (IN(5)) {
        unsigned char* hidg = (grp_id < 56) ? ws + (size_t)(133 + 2 * grp_id) * MiB : ws + (size_t)(1 + 2 * (grp_id - 56)) * MiB;
        bf16* hid0 = (bf16*)hidg - (size_t)grp_id * 256 * FF;
        swa_phase(P, lds, tid, wave, lane, (grp_id >> 4) * 256 + mi * 64 + 4 * (grp_id & 15), 1, 4);
        group_sync(gcnt, 16u, same_xcd);
        { EpiResid<true, false, false> E{nullptr, (const bf16*)(ws + WS_XA), nullptr, (bf16*)(ws + WS_XA), ss + 3 * M, dryv, 1, nullptr, 0u}; GroupOrder S{2 * grp_id, mi, 1, 1};
          run_gemm_g(lds, (const bf16*)P.out, (const bf16*)(ws + WS_SWO), D, D, S, E); }
        group_sync(gcnt, 20u, same_xcd);
        { EpiRowScale<1, false> E{hid0, FF, ss + 3 * M, nullptr}; GroupOrder S{grp_id, 4 * mi, 1, 4};
          run_gemm_g(lds, (const bf16*)(ws + WS_XA), (const bf16*)(ws + WS_UP1), FF, D, S, E); }
        group_sync(gcnt, 24u, same_xcd);
        { EpiResid<true, true, true> E{nullptr, (const bf16*)(ws + WS_XA), P.out, nullptr, nullptr, dryv, 0, nullptr, 0u}; GroupOrder S{grp_id, mi, 1, 1};
          run_gemm_g(lds, (const bf16*)hid0, (const bf16*)(ws + WS_DN1), D, FF, S, E); }
    }
#undef IN
#undef SEAM
}

#ifndef MK_PER_PHASE
#define MK_PER_PHASE 0
#endif
extern "C" void kernel_launch(void* const* d_in, const int* in_sizes, int n_in, void* d_out, int out_size, void* d_ws, size_t ws_size, hipStream_t stream) {
    static int grid = 0;
    if (grid == 0) {
        if (n_in != 17 || out_size != M * D || ws_size < WS_END) { fprintf(stderr, "kernel_launch: unexpected shapes (n_in %d out %d ws %zu)\n", n_in, out_size, ws_size); grid = -1; return; }
        int dev = 0, cus = 0, per_cu = 0;
        hipGetDevice(&dev); hipDeviceGetAttribute(&cus, hipDeviceAttributeMultiprocessorCount, dev);
        if (hipFuncSetAttribute((const void*)mega_fwd, hipFuncAttributeMaxDynamicSharedMemorySize, LDS_BYTES) != hipSuccess) { fprintf(stderr, "kernel_launch: hipFuncSetAttribute failed\n"); grid = -1; return; }
        if (hipOccupancyMaxActiveBlocksPerMultiprocessor(&per_cu, (const void*)mega_fwd, NTHR, LDS_BYTES) != hipSuccess || per_cu < 1) { fprintf(stderr, "kernel_launch: occupancy query says %d\n", per_cu); per_cu = 1; }
        (void)hipGetLastError();
        grid = cus * 1;
        if (grid != 256) { fprintf(stderr, "kernel_launch: built for 256 CUs (got %d)\n", cus); grid = 256; }
        fprintf(stderr, "kernel_launch: cus %d per_cu %d grid %d\n", cus, per_cu, grid);
    }
    if (grid < 0) return;
    if (hipMemsetAsync((char*)d_ws + WS_BAR, 0, WS_BAR_BYTES, stream) != hipSuccess) { fprintf(stderr, "kernel_launch: memset failed\n"); return; }
    Args a{};
    for (int i = 0; i < 17; ++i) a.in[i] = (const float*)d_in[i];
    a.out = (float*)d_out; a.ws = (unsigned char*)d_ws; a.rep_mask = 0; a.sync_rep = SYNC_REP;
#if MK_PER_PHASE
    for (int ph = 0; ph < NPHASE; ++ph) { a.ph_lo = ph; a.ph_hi = ph + 1; hipLaunchKernelGGL(mega_fwd, dim3(grid), dim3(NTHR), LDS_BYTES, stream, a); }
#else
    a.ph_lo = 0; a.ph_hi = NPHASE;
    void* kargs[] = {&a};
    hipError_t e = hipLaunchCooperativeKernel((const void*)mega_fwd, dim3(grid), dim3(NTHR), kargs, LDS_BYTES, stream);
    if (e != hipSuccess) fprintf(stderr, "kernel_launch: cooperative launch failed: %s (grid %d)\n", hipGetErrorString(e), grid);
#ifdef REP_EMPTY
    for (int i = 0; i < REP_EMPTY; ++i) { Args b2 = a; b2.ph_lo = NPHASE; b2.ph_hi = NPHASE; b2.rep_mask = 1; hipLaunchKernelGGL(mega_fwd, dim3(grid), dim3(NTHR), LDS_BYTES, stream, b2); }
#endif
#if REP_MASK != 0
    for (int ph = 0; ph < NPHASE; ++ph) if ((REP_MASK >> ph) & 1) { Args b2 = a; b2.ph_lo = ph; b2.ph_hi = ph + 1; b2.rep_mask = 1; hipLaunchKernelGGL(mega_fwd, dim3(grid), dim3(NTHR), LDS_BYTES, stream, b2); }
#endif
#endif
}
```
